# Optimizing an MI355X kernel written in HIP

```python
import jax, jax.numpy as jnp
from jax import lax
import numpy as np

D_MODEL = 1024
BATCH = 2
SEQ = 8192
DEPTH = 4

N_MIXERS = 3
HEAD_DIM = 64
RMS_EPS = 1e-6
SWA_Q_HEADS = D_MODEL // HEAD_DIM
SWA_KV_HEADS = SWA_Q_HEADS // 4
SWA_WINDOW = 128
ROPE_THETA = 150000.0
GLA_HEADS = 4
GLA_DK = D_MODEL // 2
GLA_DV = D_MODEL
GLA_RANK = 16
GLA_TAU = 16.0
GLA_CHUNK = 64
FOX_HEADS = D_MODEL // HEAD_DIM
FOX_BLOCK = 128
D_FF = -(-8 * D_MODEL // (3 * 256)) * 256

kernel_name = "hybrid_swa_gla_fox_adaln_trunk"


def rmsnorm(x, g):
    xf = x.astype(jnp.float32)
    y = xf * lax.rsqrt(jnp.mean(xf * xf, axis=-1, keepdims=True) + RMS_EPS)
    return (y * g.astype(jnp.float32)).astype(x.dtype)


def modulate(h, shift, scale):
    return h * (1 + scale[:, None, :]) + shift[:, None, :]


def rope(x, pos):
    hd = x.shape[-1]
    inv = 1.0 / (ROPE_THETA ** (jnp.arange(0, hd, 2, dtype=jnp.float32) / hd))
    ang = pos[:, None] * inv[None, :]
    cos = jnp.cos(ang)[None, :, None, :]
    sin = jnp.sin(ang)[None, :, None, :]
    xf = x.astype(jnp.float32)
    x1, x2 = jnp.split(xf, 2, axis=-1)
    return jnp.concatenate([x1 * cos - x2 * sin, x2 * cos + x1 * sin], axis=-1).astype(x.dtype)


def swa_mixer(h, w_in, sinks, w_o):
    B, S, _ = h.shape
    W, hd, Hq, Hkv = SWA_WINDOW, HEAD_DIM, SWA_Q_HEADS, SWA_KV_HEADS
    G = Hq // Hkv
    nb = S // W
    proj = h @ w_in
    q, k, v = jnp.split(proj, [Hq * hd, (Hq + Hkv) * hd], axis=-1)
    pos = jnp.arange(S, dtype=jnp.float32)
    q = rope(q.reshape(B, S, Hq, hd), pos)
    k = rope(k.reshape(B, S, Hkv, hd), pos)
    v = v.reshape(B, S, Hkv, hd)
    qb = q.reshape(B, nb, W, Hkv, G, hd)
    kb = k.reshape(B, nb, W, Hkv, hd)
    vb = v.reshape(B, nb, W, Hkv, hd)
    pad = ((0, 0), (1, 0), (0, 0), (0, 0), (0, 0))
    kk = jnp.concatenate([jnp.pad(kb, pad)[:, :-1], kb], axis=2)
    vv = jnp.concatenate([jnp.pad(vb, pad)[:, :-1], vb], axis=2)
    scores = jnp.einsum('bnqkgd,bnskd->bnkgqs', qb, kk).astype(jnp.float32) * (hd ** -0.5)
    i = jnp.arange(W)[:, None]
    j = jnp.arange(2 * W)[None, :]
    diff = i - j + W
    band = (diff >= 0) & (diff < W)
    has_prev = (jnp.arange(nb) > 0)[:, None, None] | (j >= W)[None]
    mask = band[None] & has_prev
    scores = jnp.where(mask[None, :, None, None], scores, -jnp.inf)
    sink_col = jnp.broadcast_to(
        sinks.astype(jnp.float32).reshape(Hkv, G)[None, None, :, :, None, None],
        scores.shape[:-1] + (1,))
    probs = jax.nn.softmax(jnp.concatenate([scores, sink_col], axis=-1), axis=-1)[..., :-1]
    out = jnp.einsum('bnkgqs,bnskd->bnqkgd', probs.astype(vv.dtype), vv)
    return out.reshape(B, S, Hq * hd) @ w_o


def gla_chunk_step(state, inp):
    q, k, v, b = inp
    C = q.shape[2]
    causal = jnp.tril(jnp.ones((C, C), dtype=bool))
    diff = b[:, :, :, None, :] - b[:, :, None, :, :]
    decay = jnp.exp(jnp.where(causal[None, None, :, :, None], diff, -jnp.inf))
    attn = jnp.einsum('bhtd,bhsd,bhtsd->bhts', q, k, decay)
    o = attn @ v + jnp.einsum('bhtd,bhde->bhte', q * jnp.exp(b), state)
    b_last = b[:, :, -1:, :]
    state = jnp.exp(b_last[:, :, 0, :])[..., None] * state + \
        jnp.einsum('bhsd,bhse->bhde', k * jnp.exp(b_last - b), v)
    return state, o


def gla_mixer(h, w_in, w_gate_up, b_gate, head_norm, w_o):
    B, S, _ = h.shape
    H, C = GLA_HEADS, GLA_CHUNK
    dk, dv = GLA_DK // H, GLA_DV // H
    nc = S // C
    proj = h @ w_in
    q, k, v, r, a_low = jnp.split(
        proj, [GLA_DK, 2 * GLA_DK, 2 * GLA_DK + GLA_DV, 2 * GLA_DK + 2 * GLA_DV], axis=-1)
    log_alpha = jax.nn.log_sigmoid((a_low @ w_gate_up + b_gate).astype(jnp.float32)) / GLA_TAU

    def to_chunks(t, d):
        return t.astype(jnp.float32).reshape(B, nc, C, H, d).transpose(1, 0, 3, 2, 4)

    qc = to_chunks(q, dk) * (dk ** -0.5)
    kc = to_chunks(k, dk)
    vc = to_chunks(v, dv)
    bc = jnp.cumsum(to_chunks(log_alpha, dk), axis=3)
    state0 = jnp.zeros((B, H, dk, dv), jnp.float32)
    _, o = lax.scan(gla_chunk_step, state0, (qc, kc, vc, bc))
    o = o.transpose(1, 0, 3, 2, 4).reshape(B, S, H, dv).astype(h.dtype)
    o = rmsnorm(o, head_norm)
    o = o * jax.nn.silu(r).reshape(B, S, H, dv)
    return o.reshape(B, S, GLA_DV) @ w_o


def fox_mixer(h, w_in, b_f, w_o):
    B, S, D = h.shape
    H, hd, blk = FOX_HEADS, HEAD_DIM, FOX_BLOCK
    proj = h @ w_in
    q, k, v, f_logit = jnp.split(proj, [D, 2 * D, 3 * D], axis=-1)
    log_f = jax.nn.log_sigmoid(f_logit.astype(jnp.float32) + b_f.astype(jnp.float32))
    lc = jnp.cumsum(log_f, axis=1).transpose(0, 2, 1)
    q = q.reshape(B, S, H, hd).transpose(0, 2, 1, 3)
    k = k.reshape(B, S, H, hd).transpose(0, 2, 1, 3)
    v = v.reshape(B, S, H, hd).transpose(0, 2, 1, 3)
    outs = []
    for i in range(S // blk):
        t0, t1 = i * blk, (i + 1) * blk
        s = jnp.einsum('bhqd,bhkd->bhqk', q[:, :, t0:t1], k[:, :, :t1]).astype(jnp.float32) * (hd ** -0.5)
        s = s + lc[:, :, t0:t1, None] - lc[:, :, None, :t1]
        mask = jnp.arange(t1)[None, :] <= (t0 + jnp.arange(blk))[:, None]
        p = jax.nn.softmax(jnp.where(mask[None, None], s, -jnp.inf), axis=-1)
        outs.append(jnp.einsum('bhqk,bhkd->bhqd', p.astype(v.dtype), v[:, :, :t1]))
    o = jnp.concatenate(outs, axis=2).transpose(0, 2, 1, 3).reshape(B, S, D)
    return o @ w_o


def swiglu(h, w_gu, w_down):
    g, u = jnp.split(h @ w_gu, 2, axis=-1)
    return (jax.nn.silu(g) * u) @ w_down


def setup_inputs(seed: int = 0) -> dict:
    key = jax.random.key(seed)
    ks = iter(jax.random.split(key, 32))
    D = D_MODEL
    n_swa, n_gla, n_fox = (DEPTH + 2) // 3, (DEPTH + 1) // 3, DEPTH // 3
    nrm = lambda k, shape, s: s * jax.random.normal(k, shape, jnp.float32)
    swa_cols = (SWA_Q_HEADS + 2 * SWA_KV_HEADS) * HEAD_DIM
    gla_cols = 2 * GLA_DK + 2 * GLA_DV + GLA_RANK
    fox_cols = 3 * D + FOX_HEADS
    return {
        "x": nrm(next(ks), (BATCH, SEQ, D), 1.0),
        "c": nrm(next(ks), (BATCH, D), 1.0),
        "ada_w": nrm(next(ks), (DEPTH, D, 6 * D), 0.5 * D ** -0.5),
        "ada_b": nrm(next(ks), (DEPTH, 6 * D), 0.02),
        "norm_gain": 1.0 + nrm(next(ks), (DEPTH, 2, D), 0.05),
        "ffn_w_gu": nrm(next(ks), (DEPTH, D, 2 * D_FF), D ** -0.5),
        "ffn_w_down": nrm(next(ks), (DEPTH, D_FF, D), D_FF ** -0.5),
        "swa_w_in": nrm(next(ks), (n_swa, D, swa_cols), D ** -0.5),
        "swa_sinks": nrm(next(ks), (n_swa, SWA_Q_HEADS), 0.5),
        "swa_w_o": nrm(next(ks), (n_swa, SWA_Q_HEADS * HEAD_DIM, D), (SWA_Q_HEADS * HEAD_DIM) ** -0.5),
        "gla_w_in": nrm(next(ks), (n_gla, D, gla_cols), D ** -0.5),
        "gla_w_gate_up": nrm(next(ks), (n_gla, GLA_RANK, GLA_DK), GLA_RANK ** -0.5),
        "gla_b_gate": nrm(next(ks), (n_gla, GLA_DK), 0.1),
        "gla_head_norm": 1.0 + nrm(next(ks), (n_gla, GLA_DV // GLA_HEADS), 0.05),
        "gla_w_o": nrm(next(ks), (n_gla, GLA_DV, D), GLA_DV ** -0.5),
        "fox_w_in": nrm(next(ks), (n_fox, D, fox_cols), D ** -0.5),
        "fox_b_f": jax.random.uniform(next(ks), (n_fox, FOX_HEADS), jnp.float32, 0.0, 3.0),
        "fox_w_o": nrm(next(ks), (n_fox, D, D), D ** -0.5),
        "final_norm": 1.0 + nrm(next(ks), (D,), 0.05),
    }


def reference(x, c, ada_w, ada_b, norm_gain, ffn_w_gu, ffn_w_down,
              swa_w_in, swa_sinks, swa_w_o,
              gla_w_in, gla_w_gate_up, gla_b_gate, gla_head_norm, gla_w_o,
              fox_w_in, fox_b_f, fox_w_o, final_norm):
    c_act = jax.nn.silu(c)
    for i in range(DEPTH):
        kind, j = i % N_MIXERS, i // N_MIXERS
        mod = c_act @ ada_w[i] + ada_b[i]
        sh1, sc1, g1, sh2, sc2, g2 = jnp.split(mod, 6, axis=-1)
        h = modulate(rmsnorm(x, norm_gain[i, 0]), sh1, sc1)
        if kind == 0:
            y = swa_mixer(h, swa_w_in[j], swa_sinks[j], swa_w_o[j])
        elif kind == 1:
            y = gla_mixer(h, gla_w_in[j], gla_w_gate_up[j], gla_b_gate[j], gla_head_norm[j], gla_w_o[j])
        else:
            y = fox_mixer(h, fox_w_in[j], fox_b_f[j], fox_w_o[j])
        x = x + g1[:, None, :] * y
        h = modulate(rmsnorm(x, norm_gain[i, 1]), sh2, sc2)
        x = x + g2[:, None, :] * swiglu(h, ffn_w_gu[i], ffn_w_down[i])
    return rmsnorm(x, final_norm)
```

```cpp
#include <hip/hip_runtime.h>
#include <cstdio>
#include <cstdint>
#include <cmath>
namespace pg8 {
#define PG8_LAS __attribute__((address_space(3)))
typedef unsigned short bf16_t;
typedef short bf16x8 __attribute__((ext_vector_type(8)));
typedef float f32x4 __attribute__((ext_vector_type(4)));
typedef unsigned u32x4 __attribute__((ext_vector_type(4)));
constexpr int BM = 256, BK = 64, HALF = 128, HTB = HALF * BK * 2  , STAGE_BYTES = 8 * HTB, NXCD = 8, WGM = 8;

__host__ __device__ __forceinline__ int lds_byte(int r, int c) { const int st = (r >> 4) * 2 + (c >> 5), rr = r & 15, cc = c & 31, ob = rr * 64 + cc * 2; return st * 1024 + (ob ^ (((ob >> 9) & 1) << 5)); }
__host__ __device__ __forceinline__ void stage_rc(int b, int& R, int& C) { const int st = b / 1024, sb = b % 1024, swz = sb ^ (((sb >> 9) & 1) << 5); R = (st >> 1) * 16 + swz / 64; C = (st & 1) * 32 + (swz % 64) / 2; }
__host__ __device__ __forceinline__ int perm32(int rho) { const int n = rho >> 4, i = rho & 15; return 8 * (i >> 2) + 4 * n + (i & 3); }

struct Unit { int pm, pn; };
struct Gemm { const bf16_t* A; const bf16_t* Bt; int M, N, K; };

struct StaticOrder {
    int nM, nN, nwg, G, c;
    __host__ __device__ void init(int M, int N, int G_, int c_) { nM = M / BM; nN = N / BM; nwg = nM * nN; G = G_; c = c_; }
    __host__ __device__ bool next(int i, Unit& u) const {
        const long L = (long)i * G + c; if (L >= nwg) return false;
        int wgid = (int)L; { const int q = nwg / NXCD, r = nwg % NXCD, xcd = wgid % NXCD, off = wgid / NXCD; wgid = (xcd < r ? xcd * (q + 1) : r * (q + 1) + (xcd - r) * q) + off; }
        const int nig = WGM * nN, gid = wgid / nig, fm = gid * WGM, gsz = (nM - fm) < WGM ? (nM - fm) : WGM;
        u.pm = fm + ((wgid % nig) % gsz); u.pn = (wgid % nig) / gsz; return true;
    }
    __device__ __forceinline__ void a_ready(const Unit&) const {}
    __device__ __forceinline__ void done(const Unit&) const {}
};


__device__ __forceinline__ unsigned cvt_pk_bf16(float lo, float hi) { unsigned r; asm volatile("v_cvt_pk_bf16_f32 %0, %1, %2" : "=v"(r) : "v"(lo), "v"(hi)); return r; }
__device__ __forceinline__ u32x4 pack8(const f32x4 a, const f32x4 b) { u32x4 w; w.x = cvt_pk_bf16(a[0], a[1]); w.y = cvt_pk_bf16(a[2], a[3]); w.z = cvt_pk_bf16(b[0], b[1]); w.w = cvt_pk_bf16(b[2], b[3]); return w; }
constexpr float K_EPS = 1e-6f, K_LOG2E = 1.4426950408889634f, K_C2 = 0.125f * 1.4426950408889634f;
__device__ __forceinline__ float row_rstd(const float* SS, int row) {
    const f32x4* p = (const f32x4*)(SS + (size_t)row * 16);
    const f32x4 a = (p[0] + p[1]) + (p[2] + p[3]);
    const float s = (a[0] + a[1]) + (a[2] + a[3]);
    return 1.0f / sqrtf(s * (1.0f / 1024.0f) + K_EPS);
}
__device__ __forceinline__ float silu_f(float v) { return v / (1.0f + __expf(-v)); }
__device__ __forceinline__ float logsigmoid_f(float v) { return fminf(v, 0.f) - log1pf(__expf(-fabsf(v))); }

struct EpiResid {
    static constexpr bool PERM = true, AFTER_DRAIN = false;
    const float* xin; float* xout; bf16_t* XA; float* SS;
    const float* gate;
    const float* nsc;
    const float* ngain;
    __device__ __forceinline__ void operator()(const f32x4 (&acc)[2][2][4][2], const Unit& u, int wr, int wc, int fr, int fq) const {
        const int b = u.pm >> 5, colt = u.pn * BM + wc * 32 + 8 * fq;
        f32x4 gv[2][2], gm[2][2];
#pragma unroll
        for (int bj = 0; bj < 2; ++bj)
#pragma unroll
            for (int n = 0; n < 2; ++n) {
                const int c = colt + bj * HALF + 4 * n;
                gv[bj][n] = *(const f32x4*)(gate + (size_t)b * 6144 + c);
                if (nsc) { const f32x4 s = *(const f32x4*)(nsc + (size_t)b * 6144 + c), g = *(const f32x4*)(ngain + c); gm[bj][n] = g * (s + 1.0f); } else gm[bj][n] = (f32x4){0.f, 0.f, 0.f, 0.f};
            }
        const int row0 = u.pm * BM + wr * 64 + fr;
#pragma unroll
        for (int ai = 0; ai < 2; ++ai)
#pragma unroll
            for (int m = 0; m < 4; ++m) {
                const int row = row0 + ai * HALF + m * 16; float ssq = 0.f;
#pragma unroll
                for (int bj = 0; bj < 2; ++bj) {
                    const size_t off = (size_t)row * 1024 + colt + bj * HALF;
                    const f32x4 x0 = *(const f32x4*)(xin + off), x1 = *(const f32x4*)(xin + off + 4);
                    const f32x4 y0 = x0 + gv[bj][0] * acc[ai][bj][m][0], y1 = x1 + gv[bj][1] * acc[ai][bj][m][1];
                    *(f32x4*)(xout + off) = y0; *(f32x4*)(xout + off + 4) = y1;
                    ssq += (y0[0] * y0[0] + y0[1] * y0[1]) + (y0[2] * y0[2] + y0[3] * y0[3]) + (y1[0] * y1[0] + y1[1] * y1[1]) + (y1[2] * y1[2] + y1[3] * y1[3]);
                    if (nsc) *(u32x4*)(XA + off) = pack8(y0 * gm[bj][0], y1 * gm[bj][1]);
                }
                ssq += __shfl_xor(ssq, 16); ssq += __shfl_xor(ssq, 32);
                if (fq == 0) SS[(size_t)row * 16 + 4 * u.pn + wc] = ssq;
            }
    }
};

struct EpiFfnGu {
    static constexpr bool PERM = true, AFTER_DRAIN = false;
    const float* SS; const float* shW  ; bf16_t* H  ;
    __device__ __forceinline__ void operator()(const f32x4 (&acc)[2][2][4][2], const Unit& u, int wr, int wc, int fr, int fq) const {
        const int b = u.pm >> 5, cw = wc * 32 + 8 * fq;
        f32x4 sg[2], su[2];
#pragma unroll
        for (int n = 0; n < 2; ++n) { sg[n] = *(const f32x4*)(shW + (size_t)b * 5632 + u.pn * BM + cw + 4 * n); su[n] = *(const f32x4*)(shW + (size_t)b * 5632 + u.pn * BM + HALF + cw + 4 * n); }
        const int row0 = u.pm * BM + wr * 64 + fr;
#pragma unroll
        for (int ai = 0; ai < 2; ++ai)
#pragma unroll
            for (int m = 0; m < 4; ++m) {
                const int row = row0 + ai * HALF + m * 16; const float rs = row_rstd(SS, row);
                f32x4 hv[2];
#pragma unroll
                for (int n = 0; n < 2; ++n) {
                    const f32x4 g = acc[ai][0][m][n] * rs + sg[n], uu = acc[ai][1][m][n] * rs + su[n];
#pragma unroll
                    for (int j = 0; j < 4; ++j) hv[n][j] = silu_f(g[j]) * uu[j];
                }
                *(u32x4*)(H + (size_t)row * 2816 + u.pn * HALF + cw) = pack8(hv[0], hv[1]);
            }
    }
};

struct EpiSwaIn {
    static constexpr bool PERM = true, AFTER_DRAIN = false;
    const float* SS; const float* shW  ; const float* ropeC; const float* ropeS;
    bf16_t *Q  , *Kb  , *Vb  ;
    __device__ __forceinline__ void operator()(const f32x4 (&acc)[2][2][4][2], const Unit& u, int wr, int wc, int fr, int fq) const {
        const int b = u.pm >> 5, cw = wc * 32 + 8 * fq;
        f32x4 sv[2][2];
#pragma unroll
        for (int bj = 0; bj < 2; ++bj)
#pragma unroll
            for (int n = 0; n < 2; ++n) sv[bj][n] = *(const f32x4*)(shW + (size_t)b * 5632 + u.pn * BM + bj * HALF + cw + 4 * n);
        const int row0 = u.pm * BM + wr * 64 + fr;
#pragma unroll
        for (int ai = 0; ai < 2; ++ai)
#pragma unroll
            for (int m = 0; m < 4; ++m) {
                const int row = row0 + ai * HALF + m * 16; const float rs = row_rstd(SS, row);
                f32x4 v[2][2];
#pragma unroll
                for (int bj = 0; bj < 2; ++bj)
#pragma unroll
                    for (int n = 0; n < 2; ++n) v[bj][n] = acc[ai][bj][m][n] * rs + sv[bj][n];
                if (u.pn < 5) {
                    const int pos = row & 8191; f32x4 o1[2], o2[2];
#pragma unroll
                    for (int n = 0; n < 2; ++n) {
                        const f32x4 c = *(const f32x4*)(ropeC + (size_t)pos * 32 + 8 * fq + 4 * n), s = *(const f32x4*)(ropeS + (size_t)pos * 32 + 8 * fq + 4 * n);
                        o1[n] = v[0][n] * c - v[1][n] * s; o2[n] = v[1][n] * c + v[0][n] * s;
                    }
                    if (u.pn < 4) {
                        bf16_t* dst = Q + (size_t)row * 1024 + (4 * u.pn + wc) * 64 + 8 * fq;
                        *(u32x4*)dst = pack8(o1[0] * K_C2, o1[1] * K_C2); *(u32x4*)(dst + 32) = pack8(o2[0] * K_C2, o2[1] * K_C2);
                    } else {
                        bf16_t* dst = Kb + (size_t)row * 256 + wc * 64 + 8 * fq;
                        *(u32x4*)dst = pack8(o1[0], o1[1]); *(u32x4*)(dst + 32) = pack8(o2[0], o2[1]);
                    }
                } else {
#pragma unroll
                    for (int bj = 0; bj < 2; ++bj) *(u32x4*)(Vb + (size_t)row * 256 + bj * HALF + cw) = pack8(v[bj][0], v[bj][1]);
                }
            }
    }
};

struct EpiFoxIn {
    static constexpr bool PERM = true, AFTER_DRAIN = false;
    const float* SS; const float* shW; bf16_t* Q; size_t tstride;
    __device__ __forceinline__ void operator()(const f32x4 (&acc)[2][2][4][2], const Unit& u, int wr, int wc, int fr, int fq) const {
        const int b = u.pm >> 5, cw = wc * 32 + 8 * fq, ty = u.pn >> 2;
        f32x4 sv[2][2];
#pragma unroll
        for (int bj = 0; bj < 2; ++bj)
#pragma unroll
            for (int n = 0; n < 2; ++n) sv[bj][n] = *(const f32x4*)(shW + (size_t)b * 5632 + u.pn * BM + bj * HALF + cw + 4 * n);
        bf16_t* base = Q + (size_t)ty * tstride; const float sc = ty == 0 ? K_C2 : 1.0f;
        const int row0 = u.pm * BM + wr * 64 + fr, col = (u.pn & 3) * BM + cw;
#pragma unroll
        for (int ai = 0; ai < 2; ++ai)
#pragma unroll
            for (int m = 0; m < 4; ++m) {
                const int row = row0 + ai * HALF + m * 16; const float rs = row_rstd(SS, row);
#pragma unroll
                for (int bj = 0; bj < 2; ++bj)
                    *(u32x4*)(base + (size_t)row * 1024 + col + bj * HALF) = pack8((acc[ai][bj][m][0] * rs + sv[bj][0]) * sc, (acc[ai][bj][m][1] * rs + sv[bj][1]) * sc);
            }
    }
};

struct EpiGlaIn {
    static constexpr bool PERM = true, AFTER_DRAIN = false;
    const float* SS; const float* shW; const float* bgate  ;
    bf16_t* R0;
    __device__ __forceinline__ void operator()(const f32x4 (&acc)[2][2][4][2], const Unit& u, int wr, int wc, int fr, int fq) const {
        const int b = u.pm >> 5, cw = wc * 32 + 8 * fq, pn = u.pn;
        f32x4 sv[2][2];
#pragma unroll
        for (int bj = 0; bj < 2; ++bj)
#pragma unroll
            for (int n = 0; n < 2; ++n) sv[bj][n] = *(const f32x4*)(shW + (size_t)b * 5632 + pn * BM + bj * HALF + cw + 4 * n);
        const int row0 = u.pm * BM + wr * 64 + fr;
        if (pn >= 12) {
            const int col = (pn - 12) * BM + cw;
            f32x4 bg[2][2];
#pragma unroll
            for (int bj = 0; bj < 2; ++bj)
#pragma unroll
                for (int n = 0; n < 2; ++n) bg[bj][n] = *(const f32x4*)(bgate + col + bj * HALF + 4 * n);
#pragma unroll
            for (int ai = 0; ai < 2; ++ai)
#pragma unroll
                for (int m = 0; m < 4; ++m) {
                    const int row = row0 + ai * HALF + m * 16; const float rs = row_rstd(SS, row);
#pragma unroll
                    for (int bj = 0; bj < 2; ++bj)
#pragma unroll
                        for (int n = 0; n < 2; ++n) { const f32x4 g = acc[ai][bj][m][n] * rs + sv[bj][n] + bg[bj][n]; f32x4 o;
#pragma unroll
                            for (int j = 0; j < 4; ++j) o[j] = logsigmoid_f(g[j]) * (1.0f / 16.0f);
                            *(f32x4*)((float*)(R0 + (size_t)48 * 1048576) + (size_t)row * 512 + col + bj * HALF + 4 * n) = o; }
                }
            return;
        }
        const bool act = (pn >= 8);
        const int offmib = (pn >= 2 ? 16 : 0) + (pn >= 4 ? 16 : 0) + (pn >= 8 ? 32 : 0);
        const int pitch = pn < 4 ? 512 : 1024; const float sc = pn < 2 ? 0.08838834764831845f : 1.0f;
        const int col = ((pn < 4) ? (pn & 1) : (pn & 3)) * BM + cw;
        bf16_t* base = R0 + (size_t)offmib * 524288;
#pragma unroll
        for (int ai = 0; ai < 2; ++ai)
#pragma unroll
            for (int m = 0; m < 4; ++m) {
                const int row = row0 + ai * HALF + m * 16; const float rs = row_rstd(SS, row);
#pragma unroll
                for (int bj = 0; bj < 2; ++bj) {
                    f32x4 a0 = (acc[ai][bj][m][0] * rs + sv[bj][0]) * sc, a1 = (acc[ai][bj][m][1] * rs + sv[bj][1]) * sc;
                    if (act) {
#pragma unroll
                        for (int j = 0; j < 4; ++j) { a0[j] = silu_f(a0[j]); a1[j] = silu_f(a1[j]); }
                    }
                    *(u32x4*)(base + (size_t)row * pitch + col + bj * HALF) = pack8(a0, a1);
                }
            }
    }
};
template <class Epi, class Sched, bool ALIGN_EPI = false, bool SP2 = false>
__device__ __forceinline__ void gemm_phase(PG8_LAS unsigned char* lds, const Gemm g, const Sched& S, const Epi& E) {
    int tid_ = threadIdx.x; asm volatile("" : "+v"(tid_));
    const int tid = tid_, wid = __builtin_amdgcn_readfirstlane(tid >> 6), lane = tid & 63, wr = wid >> 2, wc = wid & 3, fr = lane & 15, fq = lane >> 4;
    const int K = g.K, nt = K / BK;
    unsigned voffA[2], voffB[2];
#pragma unroll
    for (int i = 0; i < 2; ++i) { int R, C; stage_rc(tid * 16 + i * 8192, R, C); const int Rb = Epi::PERM ? ((R & ~31) + perm32(R & 31)) : R;
        voffA[i] = (unsigned)(R * K + C) * 2u; voffB[i] = (unsigned)(Rb * K + C) * 2u; }
    const size_t kstep = (size_t)(BK * 2);
    const size_t hstep = (size_t)HALF * K * 2;
    const size_t tstep = 2 * hstep;
    const unsigned ldsw = (unsigned)wid * 1024u;
    const int aoff = lds_byte(wr * 64 + fr, fq * 8), boff = lds_byte(wc * 32 + fr, fq * 8);
#define PG8_SA(b, h) (((b) * 2 + (h)) * HTB)
#define PG8_SB(b, h) ((4 + (b) * 2 + (h)) * HTB)
#define PG8_STAGE(bufoff, gbase, voff) do { _Pragma("unroll") for (int _i = 0; _i < 2; ++_i) \
        __builtin_amdgcn_global_load_lds((const unsigned*)((const char*)(gbase) + (voff)[_i]), (PG8_LAS unsigned*)(lds + (bufoff) + ldsw + _i * 8192), 16, 0, 0); } while (0)
#define PG8_LDA(dst, b, h) do { _Pragma("unroll") for (int m = 0; m < 4; ++m) _Pragma("unroll") for (int k = 0; k < 2; ++k) dst[m][k] = *(const PG8_LAS bf16x8*)(lds + PG8_SA(b, h) + aoff + m * 2048 + k * 1024); } while (0)
#define PG8_LDB(dst, b, h) do { _Pragma("unroll") for (int n = 0; n < 2; ++n) _Pragma("unroll") for (int k = 0; k < 2; ++k) dst[n][k] = *(const PG8_LAS bf16x8*)(lds + PG8_SB(b, h) + boff + n * 2048 + k * 1024); } while (0)
#define PG8_MMA(ai, bj, At, Bt) do { __builtin_amdgcn_s_setprio(1); _Pragma("unroll") for (int m = 0; m < 4; ++m) _Pragma("unroll") for (int n = 0; n < 2; ++n) _Pragma("unroll") for (int k = 0; k < 2; ++k) \
        acc[ai][bj][m][n] = __builtin_amdgcn_mfma_f32_16x16x32_bf16(Bt[n][k], At[m][k], acc[ai][bj][m][n], 0, 0, 0); __builtin_amdgcn_s_setprio(0); } while (0)
#define PG8_WAIT_V(n) asm volatile("s_waitcnt vmcnt(" #n ")" ::: "memory")
#define PG8_WAIT_L(n) asm volatile("s_waitcnt lgkmcnt(" #n ")" ::: "memory")
#define PG8_BAR __builtin_amdgcn_s_barrier()
#define PG8_SCHED __builtin_amdgcn_sched_barrier(0)
    Unit cur, nxt; int ui = 0;
    if (!S.next(0, cur)) return;
    f32x4 acc[2][2][4][2];
#pragma unroll
    for (int a = 0; a < 2; ++a)
#pragma unroll
        for (int b = 0; b < 2; ++b)
#pragma unroll
            for (int m = 0; m < 4; ++m)
#pragma unroll
                for (int n = 0; n < 2; ++n) acc[a][b][m][n] = (f32x4){0.f, 0.f, 0.f, 0.f};
    bf16x8 At[4][2], B0[2][2], B1[2][2];
    const char* cA = (const char*)g.A + (size_t)cur.pm * tstep; const char* cB = (const char*)g.Bt + (size_t)cur.pn * tstep;
    S.a_ready(cur);
    if constexpr (SP2) {
        PG8_STAGE(PG8_SB(0, 0), cB, voffB); PG8_STAGE(PG8_SB(0, 1), cB + hstep, voffB); PG8_STAGE(PG8_SA(0, 0), cA, voffA); PG8_STAGE(PG8_SA(0, 1), cA + hstep, voffA);
        if (wr == 1) PG8_BAR;
        PG8_WAIT_V(2); PG8_BAR;
        PG8_STAGE(PG8_SB(1, 0), cB + kstep, voffB); PG8_STAGE(PG8_SA(1, 0), cA + kstep, voffA); PG8_STAGE(PG8_SB(1, 1), cB + hstep + kstep, voffB);
        PG8_WAIT_V(6); PG8_BAR;
    } else {
        PG8_STAGE(PG8_SB(0, 0), cB, voffB); PG8_STAGE(PG8_SA(0, 0), cA, voffA); PG8_STAGE(PG8_SB(0, 1), cB + hstep, voffB); PG8_STAGE(PG8_SA(0, 1), cA + hstep, voffA);
        if (wr == 1) PG8_BAR;
        PG8_WAIT_V(4); PG8_BAR;
        PG8_STAGE(PG8_SB(1, 0), cB + kstep, voffB); PG8_STAGE(PG8_SA(1, 0), cA + kstep, voffA); PG8_STAGE(PG8_SB(1, 1), cB + hstep + kstep, voffB);
        PG8_WAIT_V(6); PG8_BAR;
    }
    for (;;) {
        const bool has_next = S.next(ui + 1, nxt);
        const char* nA = has_next ? (const char*)g.A + (size_t)nxt.pm * tstep : cA; const char* nB = has_next ? (const char*)g.Bt + (size_t)nxt.pn * tstep : cB;
        for (int t = 0; t < nt; t += 2) {
            const bool last = (t == nt - 2);
            const char* a1 = cA + (size_t)(t + 1) * kstep;
            const char* a2 = last ? nA : cA + (size_t)(t + 2) * kstep; const char* b2 = last ? nB : cB + (size_t)(t + 2) * kstep;
            const char* a3 = a2 + kstep; const char* b3 = b2 + kstep;
            if (last && has_next) S.a_ready(nxt);
            if constexpr (SP2) {
            PG8_LDB(B0, 0, 0); PG8_LDB(B1, 0, 1); PG8_SCHED; PG8_LDA(At, 0, 0); PG8_STAGE(PG8_SA(1, 1), a1 + hstep, voffA);
            PG8_WAIT_V(8); PG8_WAIT_L(0); PG8_BAR; PG8_MMA(0, 0, At, B0); PG8_MMA(0, 1, At, B1); PG8_BAR; PG8_SCHED;
            PG8_LDA(At, 0, 1); PG8_STAGE(PG8_SB(0, 0), b2, voffB); PG8_STAGE(PG8_SB(0, 1), b2 + hstep, voffB); PG8_STAGE(PG8_SA(0, 0), a2, voffA);
            PG8_WAIT_V(8); PG8_WAIT_L(0); PG8_BAR; PG8_MMA(1, 0, At, B0); PG8_MMA(1, 1, At, B1); PG8_BAR; PG8_SCHED;
            PG8_LDB(B0, 1, 0); PG8_LDB(B1, 1, 1); PG8_SCHED; PG8_LDA(At, 1, 0); PG8_STAGE(PG8_SA(0, 1), a2 + hstep, voffA);
            PG8_WAIT_V(8); PG8_WAIT_L(0); PG8_BAR; PG8_MMA(0, 0, At, B0); PG8_MMA(0, 1, At, B1); PG8_BAR; PG8_SCHED;
            PG8_LDA(At, 1, 1); PG8_STAGE(PG8_SB(1, 0), b3, voffB); PG8_STAGE(PG8_SB(1, 1), b3 + hstep, voffB); PG8_STAGE(PG8_SA(1, 0), a3, voffA);
            PG8_WAIT_V(8); PG8_WAIT_L(0); PG8_BAR; PG8_MMA(1, 0, At, B0); PG8_MMA(1, 1, At, B1); PG8_BAR; PG8_SCHED;
            } else {
            PG8_LDB(B0, 0, 0); PG8_SCHED; PG8_LDA(At, 0, 0); PG8_STAGE(PG8_SA(1, 1), a1 + hstep, voffA);
            PG8_WAIT_L(8); PG8_BAR; PG8_WAIT_L(0); PG8_MMA(0, 0, At, B0); PG8_BAR; PG8_SCHED;
            PG8_LDB(B1, 0, 1); PG8_STAGE(PG8_SB(0, 0), b2, voffB);
            PG8_BAR; PG8_WAIT_L(0); PG8_MMA(0, 1, At, B1); PG8_BAR;
            PG8_LDA(At, 0, 1); PG8_STAGE(PG8_SA(0, 0), a2, voffA);
            PG8_BAR; PG8_WAIT_L(0); PG8_MMA(1, 0, At, B0); PG8_BAR; PG8_SCHED;
            PG8_STAGE(PG8_SB(0, 1), b2 + hstep, voffB);
            PG8_WAIT_V(6); PG8_BAR; PG8_MMA(1, 1, At, B1); PG8_BAR;
            PG8_LDB(B0, 1, 0); PG8_SCHED; PG8_LDA(At, 1, 0); PG8_STAGE(PG8_SA(0, 1), a2 + hstep, voffA);
            PG8_WAIT_L(8); PG8_BAR; PG8_WAIT_L(0); PG8_MMA(0, 0, At, B0); PG8_BAR; PG8_SCHED;
            PG8_LDB(B1, 1, 1); PG8_STAGE(PG8_SB(1, 0), b3, voffB);
            PG8_BAR; PG8_WAIT_L(0); PG8_MMA(0, 1, At, B1); PG8_BAR;
            PG8_LDA(At, 1, 1); PG8_STAGE(PG8_SA(1, 0), a3, voffA);
            PG8_BAR; PG8_WAIT_L(0); PG8_MMA(1, 0, At, B0); PG8_BAR; PG8_SCHED;
            PG8_STAGE(PG8_SB(1, 1), b3 + hstep, voffB);
            PG8_WAIT_V(6); PG8_BAR; PG8_MMA(1, 1, At, B1); PG8_BAR;
            }
        }
        if constexpr (ALIGN_EPI) { if (wr == 0) PG8_BAR; }
        if constexpr (!Epi::AFTER_DRAIN) { E(acc, cur, wr, wc, fr, fq); S.done(cur); }
        if (!has_next) break;
#pragma unroll
        for (int a = 0; a < 2; ++a)
#pragma unroll
            for (int b = 0; b < 2; ++b)
#pragma unroll
                for (int m = 0; m < 4; ++m)
#pragma unroll
                    for (int n = 0; n < 2; ++n) acc[a][b][m][n] = (f32x4){0.f, 0.f, 0.f, 0.f};
        cur = nxt; cA = nA; cB = nB; ++ui;
        if constexpr (ALIGN_EPI) { if (wr == 1) PG8_BAR; }
    }
    PG8_WAIT_V(0);
    if constexpr (!ALIGN_EPI) { if (wr == 0) PG8_BAR; }
    PG8_BAR;
    if constexpr (Epi::AFTER_DRAIN) { E.fused(acc, cur, wr, wc, fr, fq, lds, wid, lane); S.done(cur); }
#undef PG8_SA
#undef PG8_SB
#undef PG8_STAGE
#undef PG8_LDA
#undef PG8_LDB
#undef PG8_MMA
#undef PG8_WAIT_V
#undef PG8_WAIT_L
#undef PG8_BAR
#undef PG8_SCHED
}
}
#define GAS __attribute__((address_space(1)))
#define LAS __attribute__((address_space(3)))
typedef unsigned short bf16;
typedef unsigned v4u __attribute__((ext_vector_type(4)));
typedef float f32x4 __attribute__((ext_vector_type(4)));
typedef short bf16x8 __attribute__((ext_vector_type(8)));
typedef GAS unsigned gu32;
typedef GAS unsigned long long gu64;
#define RLX_AGENT __ATOMIC_RELAXED, __HIP_MEMORY_SCOPE_AGENT
#define LDS_WAIT() asm volatile("s_waitcnt lgkmcnt(0)" ::: "memory")
#define VM_WAIT() asm volatile("s_waitcnt vmcnt(0)" ::: "memory")
__device__ __forceinline__ unsigned long long rt() { return __builtin_amdgcn_s_memrealtime(); }
__device__ __forceinline__ unsigned f2bf(float f) { unsigned u = __builtin_bit_cast(unsigned, f); return (u + 0x7fffu + ((u >> 16) & 1u)) >> 16; }
__device__ __forceinline__ unsigned pk2(float lo, float hi) { return f2bf(lo) | (f2bf(hi) << 16); }

#define XB_TMO      128
#define XB_XCNT(j)  (256  + 64 * (j))
#define XB_XSUB(j)  (1280 + 64 * (j))
#define XB_XGEN(j)  (2304 + 64 * (j))
#define XB_TOP      3328
#define XB_TOPGEN   3392
#define XCD_BAR_WORDS 3456
#define XB_SPIN_CAP (1u << 18)

__device__ __forceinline__ unsigned xb_ld(unsigned* p)              { return __hip_atomic_load(p, __ATOMIC_RELAXED, __HIP_MEMORY_SCOPE_AGENT); }
__device__ __forceinline__ unsigned xb_add(unsigned* p, unsigned v) { return __hip_atomic_fetch_add(p, v, __ATOMIC_RELAXED, __HIP_MEMORY_SCOPE_AGENT); }
__device__ __forceinline__ unsigned xb_xcc_id() { return (unsigned)__builtin_amdgcn_s_getreg((3 << 11) | 20) & 0xFu; }
#define XB_SPIN(cond, bar) do { unsigned _sp = 0; while (cond) { __builtin_amdgcn_s_sleep(1); \
    if ((++_sp & 255u) == 0u) { if (xb_ld(&(bar)[XB_TMO])) break; if (_sp > XB_SPIN_CAP) { atomicAdd(&(bar)[XB_TMO], 1u); break; } } } } while (0)

struct XcdBarrier {
    unsigned* bar; unsigned x;
    volatile LAS unsigned* st;
};

__device__ __forceinline__ XcdBarrier xcd_barrier_post(unsigned* bar, volatile LAS unsigned* st) {
    XcdBarrier b; b.bar = bar; b.x = xb_xcc_id(); b.st = st;
    if (threadIdx.x == 0) (void)xb_add(&bar[XB_XCNT(b.x)], 1u);
    return b;
}
__device__ __forceinline__ void xcd_barrier_complete(unsigned* bar, unsigned x, unsigned& nloc, unsigned& nx) {
    const unsigned G = gridDim.x * gridDim.y * gridDim.z;
    unsigned sum, cnt, mine, sp = 0u;
    for (;;) {
        sum = 0u; cnt = 0u; mine = 0u;
#pragma unroll
        for (unsigned j = 0; j < 16; ++j) { const unsigned c = xb_ld(&bar[XB_XCNT(j)]); sum += c; cnt += (c > 0u) ? 1u : 0u; mine = (j == x) ? c : mine; }
        if (sum == G) break;
        __builtin_amdgcn_s_sleep(1);
        if ((++sp & 255u) == 0u) { if (xb_ld(&bar[XB_TMO])) break; if (sp > XB_SPIN_CAP) { atomicAdd(&bar[XB_TMO], 1u); break; } }
    }
    nloc = mine > 0u ? mine : 1u; nx = cnt > 0u ? cnt : 1u;
}

__device__ __forceinline__ void xcd_barrier(const XcdBarrier& b) {
    asm volatile("s_waitcnt vmcnt(0)" ::: "memory");
    __syncthreads();
    if (threadIdx.x == 0) {
        unsigned* bar = b.bar;
        __builtin_amdgcn_s_waitcnt(0);
        unsigned nloc = b.st[0], nx = b.st[1];
        if (nloc == 0u) { xcd_barrier_complete(bar, b.x, nloc, nx); b.st[0] = nloc; b.st[1] = nx; }
        const unsigned old = xb_add(&bar[XB_XSUB(b.x)], 1u);
        const unsigned gen = old / nloc;
        if (old + 1u == (gen + 1u) * nloc) {
            __builtin_amdgcn_fence(__ATOMIC_RELEASE, "agent");
            asm volatile("s_waitcnt vmcnt(0)" ::: "memory");
            const unsigned og = xb_add(&bar[XB_TOP], 1u);
            const unsigned tg = og / nx;
            if (og + 1u == (tg + 1u) * nx) xb_add(&bar[XB_TOPGEN], 1u);
            else XB_SPIN(xb_ld(&bar[XB_TOPGEN]) == tg, bar);
            __builtin_amdgcn_fence(__ATOMIC_ACQUIRE, "agent");
            xb_add(&bar[XB_XGEN(b.x)], 1u);
            asm volatile("s_waitcnt vmcnt(0)" ::: "memory");
        } else {
            XB_SPIN(xb_ld(&bar[XB_XGEN(b.x)]) == gen, bar);
            __builtin_amdgcn_fence(__ATOMIC_ACQUIRE, "agent");
            asm volatile("s_waitcnt vmcnt(0)" ::: "memory");
        }
    }
    __syncthreads();
}

#ifndef MK_MULTI
#define MK_MULTI 1
#endif
constexpr int NWAVES = 8;
constexpr int M = 16384, D = 1024, SEQ = 8192, DFF = 2816, NGU = 5632, DEPTH = 4;
constexpr float EPS = 1e-6f, LOG2E = 1.4426950408889634f;
constexpr size_t MiB = 1u << 20;
constexpr size_t WS_CTL = 0, CTL_ZERO_BYTES = 1 * MiB;
constexpr size_t WS_MOD = 512 * 1024;
constexpr size_t WS_SHW = 1 * MiB;
constexpr size_t WS_ROPC = 2 * MiB, WS_ROPS = 3 * MiB;
constexpr size_t WS_SS = 4 * MiB;
constexpr size_t WS_LCL = 5 * MiB;
constexpr size_t WS_BTOT = 6 * MiB;
constexpr size_t WS_EB = 6 * MiB + 512 * 1024;
constexpr size_t WS_W = 8 * MiB;
constexpr size_t W_SWA_IN0 = WS_W, W_SWA_IN1 = WS_W + 3 * MiB, W_SWA_O0 = WS_W + 6 * MiB, W_SWA_O1 = WS_W + 8 * MiB;
constexpr size_t W_GLA_IN = WS_W + 10 * MiB, W_GLA_O = WS_W + 17 * MiB, W_FOX_IN = WS_W + 19 * MiB, W_FOX_O = WS_W + 26 * MiB;
constexpr size_t W_GU0 = WS_W + 28 * MiB, W_GU_STRIDE = 11 * MiB, W_DN0 = WS_W + 72 * MiB, W_DN_STRIDE = 5 * MiB + 512 * 1024;
constexpr size_t WS_XA = 104 * MiB;
constexpr size_t WS_R = 136 * MiB;
constexpr size_t R_H = 0;
constexpr size_t R_SQ = 0, R_SK = 32 * MiB, R_SV = 40 * MiB, R_SO = 48 * MiB;
constexpr size_t R_FQ = 0, R_FK = 32 * MiB, R_FV = 64 * MiB, R_FO = 96 * MiB;
constexpr size_t R_GQ = 0, R_GK = 16 * MiB, R_GV = 32 * MiB, R_GSR = 64 * MiB, R_GLA = 96 * MiB, R_GO = 128 * MiB, R_GA = 160 * MiB, R_GKV = 168 * MiB;
constexpr size_t WS_END = WS_R + 232 * MiB;
static_assert(W_DN0 + 4 * W_DN_STRIDE <= WS_XA && W_GU0 + 4 * W_GU_STRIDE <= W_DN0, "weight map");
constexpr int CW_BAR = 4096;
constexpr int RING_BYTES = 131072, LDSCTL_OFF = RING_BYTES, MISC_OFF = LDSCTL_OFF + 320, LDS_BYTES = 147456;
constexpr int NPHASES = 25;

struct Args { const float* in[19]; float* out; unsigned char* ws; int ph_lo, ph_hi, li, pad; };

struct Frame {
    LAS unsigned char* lds; volatile LAS unsigned* MISC; gu32* ctl;
    int tid, lane, wave, vcu, G;
};
__device__ __forceinline__ float bf2f(bf16 h) { return __uint_as_float((unsigned)h << 16); }
__device__ __forceinline__ bf16 f2bf16(float f) { return (bf16)f2bf(f); }
__device__ __forceinline__ float rbf(float f) { return bf2f(f2bf16(f)); }
__device__ __forceinline__ float wave_sum(float v) {
#pragma unroll
    for (int o = 1; o < 64; o <<= 1) v += __shfl_xor(v, o);
    return v;
}
__device__ __forceinline__ float wave_max(float v) {
#pragma unroll
    for (int o = 1; o < 64; o <<= 1) v = fmaxf(v, __shfl_xor(v, o));
    return v;
}
__device__ __forceinline__ float silu_d(float v) { return v / (1.0f + __expf(-v)); }
__device__ __forceinline__ float logsig_d(float v) { return fminf(v, 0.f) - log1pf(__expf(-fabsf(v))); }

__device__ __forceinline__ void p0_transpose_item(const float* W, int K, int pitch, bf16* WT, int n0, int lcol0, int k0, LAS float* scr, int lane) {
#pragma unroll 8
    for (int i = 0; i < 32; ++i) { const int kk = 2 * i + (lane >> 5); scr[kk * 33 + (lane & 31)] = W[(size_t)(k0 + kk) * pitch + lcol0 + (lane & 31)]; }
    LDS_WAIT(); asm volatile("" ::: "memory");
    const int c = lane & 7;
#pragma unroll
    for (int j = 0; j < 4; ++j) { const int n = (lane >> 3) + 8 * j; const LAS float* s = scr + (8 * c) * 33 + n;
        v4u o; o.x = pk2(s[0 * 33], s[1 * 33]); o.y = pk2(s[2 * 33], s[3 * 33]); o.z = pk2(s[4 * 33], s[5 * 33]); o.w = pk2(s[6 * 33], s[7 * 33]);
        *(GAS v4u*)(WT + (size_t)(n0 + n) * K + k0 + 8 * c) = o; }
    LDS_WAIT(); asm volatile("" ::: "memory");
}
__device__ __forceinline__ int map_id(int n0) { return n0; }
__device__ __forceinline__ int map_swa(int n0) { const int t = n0 >> 8, p = n0 & 255; return t < 5 ? (t << 8) + (((p >> 5) & 3) << 6) + (((p >> 7) & 1) << 5) : n0; }
__device__ __forceinline__ int map_ffn(int n0) { const int t = n0 >> 8, p = n0 & 255; return p < 128 ? 128 * t + p : 2816 + 128 * t + (p - 128); }

template <int MAP> __device__ __forceinline__ void conv_mat(Frame& F, const float* W, int K, int pitch, bf16* WT, int Nphys, int r) {
    LAS float* scr = (LAS float*)(F.lds + F.wave * 16384);
    const int nblk = Nphys / 32, kb = r / nblk, nb = r % nblk, n0 = nb * 32;
    const int l0 = MAP == 0 ? map_id(n0) : (MAP == 1 ? map_swa(n0) : map_ffn(n0));
    p0_transpose_item(W, K, pitch, WT, n0, l0, kb * 64, scr, F.lane);
}

__device__ __forceinline__ void p0_prologue(Frame& F, const Args& A) {
    unsigned char* ws = A.ws;
    const int gw = F.vcu * NWAVES + F.wave, NGW = F.G * NWAVES;
    constexpr int I_SWA_IN = 16 * (1536 / 32), I_SQ = 16 * (1024 / 32), I_GLA_IN = 16 * (3072 / 32), I_FOX_IN = 16 * (3072 / 32), I_GU = 16 * (5632 / 32), I_DN = 44 * (1024 / 32);
    constexpr int NITEMS = 2 * I_SWA_IN + 4 * I_SQ + I_GLA_IN + I_FOX_IN + 4 * I_GU + 4 * I_DN;
    for (int it = gw; it < NITEMS; it += NGW) {
        int r = it;
        if (r < 4 * I_GU) { const int l = r / I_GU; conv_mat<2>(F, A.in[5] + (size_t)l * 1024 * 5632, 1024, 5632, (bf16*)(ws + W_GU0 + l * W_GU_STRIDE), 5632, r % I_GU); continue; } r -= 4 * I_GU;
        if (r < 4 * I_DN) { const int l = r / I_DN; conv_mat<0>(F, A.in[6] + (size_t)l * 2816 * 1024, 2816, 1024, (bf16*)(ws + W_DN0 + l * W_DN_STRIDE), 1024, r % I_DN); continue; } r -= 4 * I_DN;
        if (r < 2 * I_SWA_IN) { const int j = r / I_SWA_IN; conv_mat<1>(F, A.in[7] + (size_t)j * 1024 * 1536, 1024, 1536, (bf16*)(ws + (j ? W_SWA_IN1 : W_SWA_IN0)), 1536, r % I_SWA_IN); continue; } r -= 2 * I_SWA_IN;
        if (r < 2 * I_SQ) { const int j = r / I_SQ; conv_mat<0>(F, A.in[9] + (size_t)j * 1024 * 1024, 1024, 1024, (bf16*)(ws + (j ? W_SWA_O1 : W_SWA_O0)), 1024, r % I_SQ); continue; } r -= 2 * I_SQ;
        if (r < I_GLA_IN) { conv_mat<0>(F, A.in[10], 1024, 3088, (bf16*)(ws + W_GLA_IN), 3072, r); continue; } r -= I_GLA_IN;
        if (r < I_SQ) { conv_mat<0>(F, A.in[14], 1024, 1024, (bf16*)(ws + W_GLA_O), 1024, r); continue; } r -= I_SQ;
        if (r < I_FOX_IN) { conv_mat<0>(F, A.in[15], 1024, 3088, (bf16*)(ws + W_FOX_IN), 3072, r); continue; } r -= I_FOX_IN;
        conv_mat<0>(F, A.in[17], 1024, 1024, (bf16*)(ws + W_FOX_O), 1024, r);
    }
    const int gt = (F.vcu * NWAVES + F.wave) * 64 + F.lane, NGT = NGW * 64;
    {   const float* win = A.in[10]; const float* wgu = A.in[11]; bf16* WT = (bf16*)(ws + W_GLA_IN);
        for (int i = gt; i < 512 * 1024; i += NGT) { const int j = i >> 10, k = i & 1023; float s = 0.f;
#pragma unroll
            for (int r = 0; r < 16; ++r) s += win[(size_t)k * 3088 + 3072 + r] * wgu[r * 512 + j];
            WT[(size_t)(3072 + j) * 1024 + k] = f2bf16(s); } }
    {   const float* win = A.in[15]; bf16* WT = (bf16*)(ws + W_FOX_IN);
        for (int i = gt; i < 16 * 1024; i += NGT) { const int j = i >> 10, k = i & 1023; WT[(size_t)(3072 + j) * 1024 + k] = f2bf16(win[(size_t)k * 3088 + 3072 + j]); } }
    {   float* rc = (float*)(ws + WS_ROPC); float* rs = (float*)(ws + WS_ROPS);
        for (int i = gt; i < 8192 * 32; i += NGT) { const int pos = i >> 5, d = i & 31; const double inv = exp(-(double)d * (11.918390573078392 / 32.0));
            const double rev = (double)pos * inv * 0.15915494309189535; const float f = (float)(rev - floor(rev));
            rc[i] = __builtin_amdgcn_cosf(f); rs[i] = __builtin_amdgcn_sinf(f); } }
    {   float* mod = (float*)(ws + WS_MOD); const float* c = A.in[1]; const float* aw = A.in[2]; const float* ab = A.in[3];
        for (int task = gw; task < 4 * 24 * 16; task += NGW) {
            const int kc = task & 15, jb = (task >> 4) % 24, l = task / (16 * 24);
            const int j = jb * 256 + F.lane * 4; const float* wp = aw + ((size_t)l * 1024 + kc * 64) * 6144 + j;
            f32x4 a0 = {0.f, 0.f, 0.f, 0.f}, a1 = {0.f, 0.f, 0.f, 0.f};
#pragma unroll 8
            for (int k = 0; k < 64; ++k) { const f32x4 w = *(const f32x4*)(wp + (size_t)k * 6144); const float c0 = silu_d(c[kc * 64 + k]), c1 = silu_d(c[1024 + kc * 64 + k]); a0 += w * c0; a1 += w * c1; }
            if (kc == 0) { const f32x4 bb = *(const f32x4*)(ab + (size_t)l * 6144 + j); a0 += bb; a1 += bb; }
            float* m0 = mod + ((size_t)l * 2 + 0) * 6144 + j; float* m1 = mod + ((size_t)l * 2 + 1) * 6144 + j;
#pragma unroll
            for (int q = 0; q < 4; ++q) { atomicAdd(m0 + q, a0[q]); atomicAdd(m1 + q, a1[q]); }
        } }
}

__device__ __forceinline__ void p1_prologue(Frame& F, const Args& A) {
    unsigned char* ws = A.ws; const float* mod = (const float*)(ws + WS_MOD); float* shw = (float*)(ws + WS_SHW);
    const int gw = F.vcu * NWAVES + F.wave, NGW = F.G * NWAVES, lane = F.lane;
    for (int sub = 0; sub < 8; ++sub) {
        const int l = sub >> 1; const bf16* WT; int nrows;
        if (sub & 1) { WT = (const bf16*)(ws + W_GU0 + l * W_GU_STRIDE); nrows = 5632; }
        else if (l == 0) { WT = (const bf16*)(ws + W_SWA_IN0); nrows = 1536; }
        else if (l == 1) { WT = (const bf16*)(ws + W_GLA_IN); nrows = 3584; }
        else if (l == 2) { WT = (const bf16*)(ws + W_FOX_IN); nrows = 3088; }
        else { WT = (const bf16*)(ws + W_SWA_IN1); nrows = 1536; }
        const float* sh0 = mod + ((size_t)l * 2 + 0) * 6144 + ((sub & 1) ? 3072 : 0); const float* sh1 = sh0 + 6144;
        float s0[16], s1[16];
#pragma unroll
        for (int q = 0; q < 2; ++q)
#pragma unroll
            for (int e = 0; e < 8; ++e) { s0[q * 8 + e] = sh0[q * 512 + lane * 8 + e]; s1[q * 8 + e] = sh1[q * 512 + lane * 8 + e]; }
        for (int n = gw; n < nrows; n += NGW) {
            float a0 = 0.f, a1 = 0.f;
#pragma unroll
            for (int q = 0; q < 2; ++q) { const v4u w = *(const GAS v4u*)(WT + (size_t)n * 1024 + q * 512 + lane * 8);
                const unsigned ww[4] = {w.x, w.y, w.z, w.w};
#pragma unroll
                for (int e = 0; e < 4; ++e) { const float lo = __uint_as_float(ww[e] << 16), hi = __uint_as_float(ww[e] & 0xffff0000u);
                    a0 += lo * s0[q * 8 + 2 * e] + hi * s0[q * 8 + 2 * e + 1]; a1 += lo * s1[q * 8 + 2 * e] + hi * s1[q * 8 + 2 * e + 1]; } }
            a0 = wave_sum(a0); a1 = wave_sum(a1);
            if (lane == 0) { shw[((size_t)sub * 2 + 0) * 5632 + n] = a0; shw[((size_t)sub * 2 + 1) * 5632 + n] = a1; }
        }
    }
    const float* x = A.in[0]; const float* ng = A.in[4]; bf16* XA = (bf16*)(ws + WS_XA); float* SS = (float*)(ws + WS_SS);
    for (int row = gw; row < M; row += NGW) {
        const int b = row >> 13; const GAS f32x4* xr = (const GAS f32x4*)(x + (size_t)row * D) + lane; const float* sc = mod + (size_t)b * 6144 + 1024;
        float s = 0.f; GAS unsigned long long* o8 = (GAS unsigned long long*)(XA + (size_t)row * D) + lane;
#pragma unroll
        for (int j = 0; j < 4; ++j) { const f32x4 v = xr[64 * j]; s += (v.x * v.x + v.y * v.y) + (v.z * v.z + v.w * v.w);
            const int k = 256 * j + 4 * lane; const f32x4 g = *(const f32x4*)(ng + k), c = *(const f32x4*)(sc + k); const f32x4 y = v * (g * (c + 1.0f));
            o8[64 * j] = (unsigned long long)pk2(y.x, y.y) | ((unsigned long long)pk2(y.z, y.w) << 32); }
        s = wave_sum(s);
        if (lane < 16) SS[(size_t)row * 16 + lane] = lane == 0 ? s : 0.f;
    }
}

__device__ __forceinline__ void final_norm_phase(Frame& F, const Args& A) {
    const int gw = F.vcu * NWAVES + F.wave, NGW = F.G * NWAVES, lane = F.lane; const float* SS = (const float*)(A.ws + WS_SS); const float* fg = A.in[18];
    for (int row = gw; row < M; row += NGW) {
        const float rs = pg8::row_rstd(SS, row); GAS f32x4* xr = (GAS f32x4*)(A.out + (size_t)row * D) + lane;
#pragma unroll
        for (int j = 0; j < 4; ++j) { const f32x4 v = xr[64 * j]; const f32x4 g = *(const f32x4*)(fg + 256 * j + 4 * lane); xr[64 * j] = v * rs * g; }
    }
}

__device__ __forceinline__ void load_row64(const bf16* p, float (&q)[64]) {
#pragma unroll
    for (int i = 0; i < 8; ++i) { const v4u w = *(const GAS v4u*)(p + 8 * i); const unsigned ww[4] = {w.x, w.y, w.z, w.w};
#pragma unroll
        for (int e = 0; e < 4; ++e) { q[8 * i + 2 * e] = __uint_as_float(ww[e] << 16); q[8 * i + 2 * e + 1] = __uint_as_float(ww[e] & 0xffff0000u); } }
}
__device__ __forceinline__ float dot_row64(const bf16* p, const float (&q)[64]) {
    float s = 0.f;
#pragma unroll
    for (int i = 0; i < 8; ++i) { const v4u w = *(const GAS v4u*)(p + 8 * i); const unsigned ww[4] = {w.x, w.y, w.z, w.w};
#pragma unroll
        for (int e = 0; e < 4; ++e) { s += __uint_as_float(ww[e] << 16) * q[8 * i + 2 * e]; s += __uint_as_float(ww[e] & 0xffff0000u) * q[8 * i + 2 * e + 1]; } }
    return s;
}
__device__ __forceinline__ void swa_simple(Frame& F, const bf16* Q, const bf16* Kb, const bf16* Vb, bf16* O, const float* sinks) {
    const int gw = blockIdx.x * NWAVES + F.wave, NGW = F.G * NWAVES, lane = F.lane;
    for (int task = gw; task < M * 16; task += NGW) {
        const int row = task >> 4, h = task & 15, t = row & 8191, rowb = row - t, kvh = h >> 2;
        float q[64]; load_row64(Q + (size_t)row * 1024 + h * 64, q);
        const int s0 = t - lane, s1 = t - 64 - lane;
        const float sc0 = s0 >= 0 ? dot_row64(Kb + (size_t)(rowb + s0) * 256 + kvh * 64, q) : -INFINITY;
        const float sc1 = s1 >= 0 ? dot_row64(Kb + (size_t)(rowb + s1) * 256 + kvh * 64, q) : -INFINITY;
        const float sk = sinks[h] * LOG2E;
        const float m = fmaxf(wave_max(fmaxf(sc0, sc1)), sk);
        const float p0 = exp2f(sc0 - m), p1 = exp2f(sc1 - m);
        const float l = wave_sum(p0 + p1) + exp2f(sk - m);
        float acc = 0.f;
        for (int j = 0; j < 64; ++j) { const int s = t - j; if (s < 0) break; acc += __shfl(p0, j) * bf2f(Vb[(size_t)(rowb + s) * 256 + kvh * 64 + lane]); }
        for (int j = 0; j < 64; ++j) { const int s = t - 64 - j; if (s < 0) break; acc += __shfl(p1, j) * bf2f(Vb[(size_t)(rowb + s) * 256 + kvh * 64 + lane]); }
        O[(size_t)row * 1024 + h * 64 + lane] = f2bf16(acc / l);
    }
}
__device__ __forceinline__ void fox_simple(Frame& F, const bf16* Q, const bf16* Kb, const bf16* Vb, bf16* O, const float* LCL, const float* BTOT) {
    const int gw = blockIdx.x * NWAVES + F.wave, NGW = F.G * NWAVES, lane = F.lane;
    for (int task = gw; task < M * 16; task += NGW) {
        const int row = task >> 4, h = task & 15, t = row & 8191, rowb = row - t, b = row >> 13;
        float q[64]; load_row64(Q + (size_t)row * 1024 + h * 64, q);
        const float bt = lane < 32 ? BTOT[(b * 16 + h) * 32 + lane] : 0.f; float inc = bt;
#pragma unroll
        for (int o = 1; o < 32; o <<= 1) { const float v = __shfl_up(inc, o); if (lane >= o) inc += v; }
        const float excl = inc - bt;
        const float lct = LCL[(size_t)row * 16 + h] + __shfl(excl, t >> 8);
        float m = -1e30f, l = 0.f, o = 0.f;
        for (int c = 0; c <= (t >> 6); ++c) {
            const int s = 64 * c + lane; const bool valid = s <= t; const float base = __shfl(excl, c >> 2);
            float sc = -INFINITY;
            if (valid) sc = dot_row64(Kb + (size_t)(rowb + s) * 1024 + h * 64, q) + LOG2E * (lct - (LCL[(size_t)(rowb + s) * 16 + h] + base));
            const float mn = fmaxf(m, wave_max(sc)); const float alpha = exp2f(m - mn); const float p = exp2f(sc - mn);
            l = l * alpha + wave_sum(p); o *= alpha;
            const int nj = min(64, t - 64 * c + 1);
            for (int j = 0; j < nj; ++j) o += __shfl(p, j) * bf2f(Vb[(size_t)(rowb + 64 * c + j) * 1024 + h * 64 + lane]);
            m = mn;
        }
        O[(size_t)row * 1024 + h * 64 + lane] = f2bf16(o / l);
    }
}
__device__ __forceinline__ void fox_gate_unit(Frame& F, int blk, const bf16* XA, const bf16* Wf  , const float* SS, const float* shWf  , const float* b_f, float* LCL, float* BTOT) {
    LAS bf16* wl = (LAS bf16*)F.lds; LAS float* lf = (LAS float*)(F.lds + 32768); LAS float* seg = (LAS float*)(F.lds + 32768 + 16384);
    const int tid = F.tid, lane = F.lane, wave = F.wave;
    for (int i = tid; i < 16 * 1024 / 8; i += 512) ((LAS v4u*)wl)[i] = ((const GAS v4u*)Wf)[i];
    LDS_WAIT(); __syncthreads();
    const int b = (blk * 256) >> 13;
    for (int r = 0; r < 32; ++r) {
        const int tl = wave * 32 + r, row = blk * 256 + tl;
        float xa[16];
#pragma unroll
        for (int q = 0; q < 2; ++q) { const v4u w = *(const GAS v4u*)(XA + (size_t)row * 1024 + q * 512 + lane * 8); const unsigned ww[4] = {w.x, w.y, w.z, w.w};
#pragma unroll
            for (int e = 0; e < 4; ++e) { xa[q * 8 + 2 * e] = __uint_as_float(ww[e] << 16); xa[q * 8 + 2 * e + 1] = __uint_as_float(ww[e] & 0xffff0000u); } }
        const float rs = pg8::row_rstd(SS, row);
        float mine = 0.f;
#pragma unroll
        for (int h = 0; h < 16; ++h) { float a = 0.f;
#pragma unroll
            for (int q = 0; q < 2; ++q) { const v4u w = *(const LAS v4u*)(wl + h * 1024 + q * 512 + lane * 8); const unsigned ww[4] = {w.x, w.y, w.z, w.w};
#pragma unroll
                for (int e = 0; e < 4; ++e) { a += __uint_as_float(ww[e] << 16) * xa[q * 8 + 2 * e]; a += __uint_as_float(ww[e] & 0xffff0000u) * xa[q * 8 + 2 * e + 1]; } }
            a = wave_sum(a); if (lane == h) mine = a; }
        if (lane < 16) lf[tl * 16 + lane] = logsig_d(mine * rs + shWf[(size_t)b * 5632 + 3072 + lane] + b_f[lane]);
    }
    LDS_WAIT(); __syncthreads();
    const int h = tid & 15, sg = tid >> 4;
    float loc[8]; float run = 0.f;
#pragma unroll
    for (int i = 0; i < 8; ++i) { run += lf[(sg * 8 + i) * 16 + h]; loc[i] = run; }
    seg[sg * 16 + h] = run;
    LDS_WAIT(); __syncthreads();
    float pre = 0.f;
    for (int s2 = 0; s2 < sg; ++s2) pre += seg[s2 * 16 + h];
#pragma unroll
    for (int i = 0; i < 8; ++i) LCL[(size_t)(blk * 256 + sg * 8 + i) * 16 + h] = pre + loc[i];
    if (sg == 31) BTOT[(b * 16 + h) * 32 + (blk & 31)] = pre + run;
    LDS_WAIT(); __syncthreads();
}

__device__ __forceinline__ void gla_A_simple(Frame& F, bf16* Qg, bf16* Kg, const bf16* Vg, const float* LA, float* EB, bf16* Ag, bf16* KV) {
    LAS float* Bc = (LAS float*)F.lds;
    LAS float* Qp = (LAS float*)(F.lds + 32768);
    LAS float* Kp = (LAS float*)(F.lds + 32768 + 33024);
    LAS bf16* Vl = (LAS bf16*)(F.lds + 32768 + 2 * 33024);
    const int tid = F.tid;
    for (int unit = blockIdx.x; unit < 1024; unit += F.G) {
        const int b = unit >> 9, n = (unit >> 2) & 127, h = unit & 3, row0 = b * 8192 + n * 64;
        for (int i = tid; i < 64 * 128; i += 512) { const int t = i >> 7, d = i & 127; Bc[i] = LA[(size_t)(row0 + t) * 512 + h * 128 + d]; }
        for (int i = tid; i < 64 * 256 / 8; i += 512) { const int t = i >> 5, c = i & 31; ((LAS v4u*)Vl)[i] = *(const GAS v4u*)(Vg + (size_t)(row0 + t) * 1024 + h * 256 + c * 8); }
        LDS_WAIT(); __syncthreads();
        if (tid < 128) { float a = 0.f; for (int t = 0; t < 64; ++t) { a += Bc[t * 128 + tid]; Bc[t * 128 + tid] = a; } EB[(size_t)unit * 128 + tid] = __expf(a); }
        LDS_WAIT(); __syncthreads();
        for (int i = tid; i < 64 * 128; i += 512) { const int t = i >> 7, d = i & 127; const float bb = Bc[i]; const size_t g = (size_t)(row0 + t) * 512 + h * 128 + d;
            const bf16 qp = f2bf16(bf2f(Qg[g]) * __expf(bb)), kp = f2bf16(bf2f(Kg[g]) * __expf(-bb));
            Qg[g] = qp; Kg[g] = kp; Qp[t * 129 + d] = bf2f(qp); Kp[t * 129 + d] = bf2f(kp); }
        LDS_WAIT(); __syncthreads();
        {   const int t = tid >> 3, sg = tid & 7;
#pragma unroll
            for (int i = 0; i < 8; ++i) { const int s = sg + 8 * i; float a = 0.f;
                if (s <= t) { for (int d = 0; d < 128; ++d) a += Qp[t * 129 + d] * Kp[s * 129 + d]; }
                Ag[(size_t)unit * 4096 + t * 64 + s] = f2bf16(a); } }
        {   const int d = tid >> 2, eg = tid & 3;
            float acc[64];
#pragma unroll
            for (int i = 0; i < 64; ++i) acc[i] = 0.f;
            for (int s = 0; s < 64; ++s) { const float kp = Kp[s * 129 + d];
#pragma unroll
                for (int i = 0; i < 32; ++i) { const unsigned w = *(const LAS unsigned*)(Vl + s * 256 + eg * 64 + 2 * i); acc[2 * i] += kp * __uint_as_float(w << 16); acc[2 * i + 1] += kp * __uint_as_float(w & 0xffff0000u); } }
            bf16* dst = KV + ((size_t)unit * 128 + d) * 256 + eg * 64;
#pragma unroll
            for (int i = 0; i < 8; ++i) { v4u o; o.x = pk2(acc[8 * i], acc[8 * i + 1]); o.y = pk2(acc[8 * i + 2], acc[8 * i + 3]); o.z = pk2(acc[8 * i + 4], acc[8 * i + 5]); o.w = pk2(acc[8 * i + 6], acc[8 * i + 7]); *(GAS v4u*)(dst + 8 * i) = o; } }
        LDS_WAIT(); __syncthreads();
    }
}
__device__ __forceinline__ void gla_B_scan(Frame& F, bf16* KV, const float* EB) {
    const int idx = blockIdx.x * 512 + F.tid;
    for (int p = idx; p < 131072; p += F.G * 512) {
        const int e2 = p & 127, d = (p >> 7) & 127, h = (p >> 14) & 3, b = p >> 16;
        float s0 = 0.f, s1 = 0.f;
        for (int n0 = 0; n0 < 128; n0 += 8) {
            unsigned kv[8]; float eb[8];
#pragma unroll
            for (int i = 0; i < 8; ++i) { const size_t unit = (size_t)(b * 128 + n0 + i) * 4 + h; kv[i] = *(const GAS unsigned*)(KV + (unit * 128 + d) * 256 + 2 * e2); eb[i] = EB[unit * 128 + d]; }
#pragma unroll
            for (int i = 0; i < 8; ++i) { const size_t unit = (size_t)(b * 128 + n0 + i) * 4 + h;
                *(GAS unsigned*)(KV + (unit * 128 + d) * 256 + 2 * e2) = pk2(s0, s1);
                s0 = eb[i] * (s0 + __uint_as_float(kv[i] << 16)); s1 = eb[i] * (s1 + __uint_as_float(kv[i] & 0xffff0000u)); }
        }
    }
}
__device__ __forceinline__ void gla_C_simple(Frame& F, const bf16* Qg, const bf16* Vg, const bf16* SR, const bf16* Ag, const bf16* Sg, const float* hn, bf16* O) {
    LAS bf16* Sl = (LAS bf16*)F.lds;
    LAS bf16* Vl = (LAS bf16*)(F.lds + 65536);
    LAS float* Al = (LAS float*)(F.lds + 98304);
    LAS float* Ql = (LAS float*)(F.lds + 98304 + 16640);
    LAS bf16* Qb = (LAS bf16*)Ql;
    const int tid = F.tid;
    for (int unit = blockIdx.x; unit < 1024; unit += F.G) {
        const int b = unit >> 9, n = (unit >> 2) & 127, h = unit & 3, row0 = b * 8192 + n * 64;
        for (int i = tid; i < 128 * 256 / 8; i += 512) ((LAS v4u*)Sl)[i] = *(const GAS v4u*)(Sg + (size_t)unit * 32768 + (size_t)i * 8);
        for (int i = tid; i < 64 * 256 / 8; i += 512) { const int t = i >> 5, c = i & 31; ((LAS v4u*)Vl)[i] = *(const GAS v4u*)(Vg + (size_t)(row0 + t) * 1024 + h * 256 + c * 8); }
        for (int i = tid; i < 4096; i += 512) Al[(i >> 6) * 65 + (i & 63)] = bf2f(Ag[(size_t)unit * 4096 + i]);
        for (int i = tid; i < 64 * 128; i += 512) { const int t = i >> 7, d = i & 127; Qb[t * 136 + d] = Qg[(size_t)(row0 + t) * 512 + h * 128 + d]; }
        LDS_WAIT(); __syncthreads();
        const int t = tid >> 3, eg = tid & 7;
        float acc[32];
#pragma unroll
        for (int i = 0; i < 32; ++i) acc[i] = 0.f;
        for (int s = 0; s < 64; ++s) { const float a = Al[t * 65 + s];
#pragma unroll
            for (int i = 0; i < 16; ++i) { const unsigned w = *(const LAS unsigned*)(Vl + s * 256 + eg * 32 + 2 * i); acc[2 * i] += a * __uint_as_float(w << 16); acc[2 * i + 1] += a * __uint_as_float(w & 0xffff0000u); } }
        for (int d = 0; d < 128; ++d) { const float qv = bf2f(Qb[t * 136 + d]);
#pragma unroll
            for (int i = 0; i < 16; ++i) { const unsigned w = *(const LAS unsigned*)(Sl + d * 256 + eg * 32 + 2 * i); acc[2 * i] += qv * __uint_as_float(w << 16); acc[2 * i + 1] += qv * __uint_as_float(w & 0xffff0000u); } }
        float ss = 0.f;
#pragma unroll
        for (int i = 0; i < 32; ++i) ss += acc[i] * acc[i];
        ss += __shfl_xor(ss, 1); ss += __shfl_xor(ss, 2); ss += __shfl_xor(ss, 4);
        const float rs = 1.0f / sqrtf(ss * (1.0f / 256.0f) + EPS);
        const bf16* srp = SR + (size_t)(row0 + t) * 1024 + h * 256 + eg * 32; bf16* op = O + (size_t)(row0 + t) * 1024 + h * 256 + eg * 32;
#pragma unroll
        for (int i = 0; i < 4; ++i) { const v4u w = *(const GAS v4u*)(srp + 8 * i); const unsigned ww[4] = {w.x, w.y, w.z, w.w}; unsigned oo[4];
#pragma unroll
            for (int e = 0; e < 4; ++e) { const int c = 8 * i + 2 * e; const float v0 = acc[c] * rs * hn[eg * 32 + c] * __uint_as_float(ww[e] << 16), v1 = acc[c + 1] * rs * hn[eg * 32 + c + 1] * __uint_as_float(ww[e] & 0xffff0000u); oo[e] = pk2(v0, v1); }
            v4u o; o.x = oo[0]; o.y = oo[1]; o.z = oo[2]; o.w = oo[3]; *(GAS v4u*)(op + 8 * i) = o; }
        LDS_WAIT(); __syncthreads();
    }
}

__device__ __forceinline__ Frame make_frame(unsigned char* lds_generic) {
    Frame F; int t = threadIdx.x; asm volatile("" : "+v"(t));
    F.lds = (LAS unsigned char*)lds_generic; F.MISC = (volatile LAS unsigned*)(F.lds + MISC_OFF);
    F.tid = t; F.lane = t & 63; F.wave = __builtin_amdgcn_readfirstlane(t >> 6);
    F.G = gridDim.x; { const int bx = blockIdx.x; F.vcu = (F.G % 8 == 0) ? (bx % 8) * (F.G / 8) + bx / 8 : bx; }
    F.ctl = nullptr;
    return F;
}
__global__ void __launch_bounds__(NWAVES * 64, 2) skel_fwd(Args args) {
    extern __shared__ __attribute__((aligned(16))) unsigned char lds[];
    {   LAS unsigned char* l3 = (LAS unsigned char*)lds;
        for (int u = threadIdx.x; u < (LDS_BYTES - LDSCTL_OFF) / 4; u += NWAVES * 64) ((LAS unsigned*)(l3 + LDSCTL_OFF))[u] = 0u;
        __syncthreads(); }
#if !MK_MULTI
    XcdBarrier bar = xcd_barrier_post((unsigned*)((gu32*)(args.ws + WS_CTL) + CW_BAR), (volatile LAS unsigned*)((LAS unsigned char*)lds + MISC_OFF) + 8);
#endif
    const int lo = args.ph_lo, hi = args.ph_hi; int ph = 0;
#define PH_ON (ph >= lo && ph < hi)
#define PH_BEGIN if (PH_ON) { Frame F = make_frame(lds); unsigned char* ws = args.ws; asm volatile("" : "+s"(ws)); int l = lraw; asm volatile("" : "+s"(l)); (void)F; (void)l;
#if MK_MULTI
#define PH_END } ++ph;
#else
#define PH_END } if (PH_ON && (ph + 1) < hi) xcd_barrier(bar); ++ph;
#endif
#define P_MOD ((const float*)(ws + WS_MOD))
#define P_SS ((float*)(ws + WS_SS))
#define P_SHW(sub) ((const float*)(ws + WS_SHW) + (size_t)(sub) * 2 * 5632)
#define P_XA ((bf16*)(ws + WS_XA))
#define P_R (ws + WS_R)
    int lraw = 0;
    PH_BEGIN p0_prologue(F, args); PH_END
    PH_BEGIN p1_prologue(F, args); PH_END

    for (lraw = 0; lraw < DEPTH; ++lraw) {
        const int kind = lraw % 3;
        if (kind == 0) {
            PH_BEGIN
                const int j = l / 3;
                pg8::Gemm g{P_XA, (const bf16*)(ws + (j ? W_SWA_IN1 : W_SWA_IN0)), M, 1536, 1024}; pg8::StaticOrder S; S.init(M, 1536, F.G, (int)blockIdx.x);
                pg8::EpiSwaIn E{P_SS, P_SHW(2 * l), (const float*)(ws + WS_ROPC), (const float*)(ws + WS_ROPS), (bf16*)(P_R + R_SQ), (bf16*)(P_R + R_SK), (bf16*)(P_R + R_SV)};
                pg8::gemm_phase<pg8::EpiSwaIn, pg8::StaticOrder, true, true>(F.lds, g, S, E);
            PH_END
            PH_BEGIN
                swa_simple(F, (const bf16*)(P_R + R_SQ), (const bf16*)(P_R + R_SK), (const bf16*)(P_R + R_SV), (bf16*)(P_R + R_SO), args.in[8] + (l / 3) * 16);
            PH_END
        } else if (kind == 1) {
            PH_BEGIN
                pg8::Gemm g{P_XA, (const bf16*)(ws + W_GLA_IN), M, 3584, 1024}; pg8::StaticOrder S; S.init(M, 3584, F.G, (int)blockIdx.x);
                pg8::EpiGlaIn E{P_SS, P_SHW(2 * l), args.in[12], (bf16*)P_R};
                static_assert(R_GQ == 0 && R_GK == 16 * MiB && R_GV == 32 * MiB && R_GSR == 64 * MiB && R_GLA == 96 * MiB, "EpiGlaIn offsets");
                pg8::gemm_phase<pg8::EpiGlaIn, pg8::StaticOrder, true, true>(F.lds, g, S, E);
            PH_END
            PH_BEGIN
                gla_A_simple(F, (bf16*)(P_R + R_GQ), (bf16*)(P_R + R_GK), (const bf16*)(P_R + R_GV), (const float*)(P_R + R_GLA), (float*)(ws + WS_EB), (bf16*)(P_R + R_GA), (bf16*)(P_R + R_GKV));
            PH_END
            PH_BEGIN
                gla_B_scan(F, (bf16*)(P_R + R_GKV), (const float*)(ws + WS_EB));
            PH_END
            PH_BEGIN
                gla_C_simple(F, (const bf16*)(P_R + R_GQ), (const bf16*)(P_R + R_GV), (const bf16*)(P_R + R_GSR), (const bf16*)(P_R + R_GA), (const bf16*)(P_R + R_GKV), args.in[13], (bf16*)(P_R + R_GO));
            PH_END
        } else {
            PH_BEGIN
                pg8::Gemm g{P_XA, (const bf16*)(ws + W_FOX_IN), M, 3072, 1024}; pg8::StaticOrder S; S.init(M, 3072, F.G, (int)blockIdx.x);
                pg8::EpiFoxIn E{P_SS, P_SHW(2 * l), (bf16*)(P_R + R_FQ), (size_t)(R_FK - R_FQ) / 2};
                static_assert(R_FV - R_FK == R_FK - R_FQ, "EpiFoxIn stride");
                pg8::gemm_phase<pg8::EpiFoxIn, pg8::StaticOrder, true, true>(F.lds, g, S, E);
                for (int blk = blockIdx.x; blk < 64; blk += F.G)
                    fox_gate_unit(F, blk, P_XA, (const bf16*)(ws + W_FOX_IN) + (size_t)3072 * 1024, P_SS, P_SHW(2 * l), args.in[16], (float*)(ws + WS_LCL), (float*)(ws + WS_BTOT));
            PH_END
            PH_BEGIN
                fox_simple(F, (const bf16*)(P_R + R_FQ), (const bf16*)(P_R + R_FK), (const bf16*)(P_R + R_FV), (bf16*)(P_R + R_FO), (const float*)(ws + WS_LCL), (const float*)(ws + WS_BTOT));
            PH_END
        }
        PH_BEGIN
            const int kd = l % 3; const float* modl = P_MOD + (size_t)l * 2 * 6144;
            const bf16* Omix = (const bf16*)(P_R + (kd == 0 ? R_SO : (kd == 1 ? R_GO : R_FO)));
            const bf16* Wo = (const bf16*)(ws + (kd == 0 ? (l ? W_SWA_O1 : W_SWA_O0) : (kd == 1 ? W_GLA_O : W_FOX_O)));
            pg8::Gemm g{Omix, Wo, M, 1024, 1024}; pg8::StaticOrder S; S.init(M, 1024, F.G, (int)blockIdx.x);
            pg8::EpiResid E{l == 0 ? args.in[0] : (const float*)args.out, args.out, P_XA, P_SS, modl + 2048, modl + 4096, args.in[4] + (size_t)(2 * l + 1) * 1024};
            pg8::gemm_phase<pg8::EpiResid, pg8::StaticOrder, false, true>(F.lds, g, S, E);
        PH_END
        PH_BEGIN
            pg8::Gemm g{P_XA, (const bf16*)(ws + W_GU0 + l * W_GU_STRIDE), M, NGU, 1024}; pg8::StaticOrder S; S.init(M, NGU, F.G, (int)blockIdx.x);
            pg8::EpiFfnGu E{P_SS, P_SHW(2 * l + 1), (bf16*)(P_R + R_H)};
            pg8::gemm_phase<pg8::EpiFfnGu, pg8::StaticOrder, true, true>(F.lds, g, S, E);
        PH_END
        PH_BEGIN
            const float* modl = P_MOD + (size_t)l * 2 * 6144; const bool last = (l == DEPTH - 1);
            pg8::Gemm g{(const bf16*)(P_R + R_H), (const bf16*)(ws + W_DN0 + l * W_DN_STRIDE), M, 1024, DFF}; pg8::StaticOrder S; S.init(M, 1024, F.G, (int)blockIdx.x);
            pg8::EpiResid E{args.out, args.out, P_XA, P_SS, modl + 5120, last ? nullptr : (modl + 2 * 6144 + 1024), last ? nullptr : (args.in[4] + (size_t)(2 * l + 2) * 1024)};
            pg8::gemm_phase<pg8::EpiResid, pg8::StaticOrder, false, true>(F.lds, g, S, E);
        PH_END
    }
    lraw = 0;
    PH_BEGIN final_norm_phase(F, args); PH_END
#undef PH_ON
#undef PH_BEGIN
#undef PH_END
}

extern "C" void kernel_launch(void* const* d_in, const int* in_sizes, int n_in, void* d_out, int out_size, void* d_ws, size_t ws_size, hipStream_t stream) {
    static int grid = 0;
    if (grid == 0) {
        if (n_in != 19 || in_sizes[0] != M * D || out_size != M * D || ws_size < WS_END) { fprintf(stderr, "kernel_launch: unexpected problem shape (n_in %d, in0 %d, out %d, ws %zu)\n", n_in, n_in > 0 ? in_sizes[0] : -1, out_size, ws_size); grid = -1; return; }
        int dev = 0, cus = 0;
        if (hipGetDevice(&dev) != hipSuccess || hipDeviceGetAttribute(&cus, hipDeviceAttributeMultiprocessorCount, dev) != hipSuccess) { grid = -1; return; }
        if (hipFuncSetAttribute((const void*)skel_fwd, hipFuncAttributeMaxDynamicSharedMemorySize, LDS_BYTES) != hipSuccess) { fprintf(stderr, "kernel_launch: hipFuncSetAttribute failed\n"); grid = -1; return; }
        (void)hipGetLastError();
        grid = cus;
    }
    if (grid < 0) return;
    if (hipMemsetAsync((char*)d_ws + WS_CTL, 0, CTL_ZERO_BYTES, stream) != hipSuccess) return;
    Args a{};
    for (int i = 0; i < 19; ++i) a.in[i] = (const float*)d_in[i];
    a.out = (float*)d_out; a.ws = (unsigned char*)d_ws;
#if MK_MULTI
    for (int p = 0; p < NPHASES; ++p) { a.ph_lo = p; a.ph_hi = p + 1; a.li = 0; hipLaunchKernelGGL(skel_fwd, dim3(grid), dim3(NWAVES * 64), LDS_BYTES, stream, a); }
#else
    a.ph_lo = 0; a.ph_hi = NPHASES; a.li = 0;
    hipLaunchKernelGGL(skel_fwd, dim3(grid), dim3(NWAVES * 64), LDS_BYTES, stream, a);
#endif
}
```

```cpp
#include <hip/hip_runtime.h>
#include <cstdio>
#include <cstdint>
#include <cmath>
namespace pg8 {
#define PG8_LAS __attribute__((address_space(3)))
typedef unsigned short bf16_t;
typedef short bf16x8 __attribute__((ext_vector_type(8)));
typedef float f32x4 __attribute__((ext_vector_type(4)));
typedef unsigned u32x4 __attribute__((ext_vector_type(4)));
constexpr int BM = 256, BK = 64, HALF = 128, HTB = HALF * BK * 2  , STAGE_BYTES = 8 * HTB, NXCD = 8, WGM = 8;

__host__ __device__ __forceinline__ int lds_byte(int r, int c) { const int st = (r >> 4) * 2 + (c >> 5), rr = r & 15, cc = c & 31, ob = rr * 64 + cc * 2; return st * 1024 + (ob ^ (((ob >> 9) & 1) << 5)); }
__host__ __device__ __forceinline__ void stage_rc(int b, int& R, int& C) { const int st = b / 1024, sb = b % 1024, swz = sb ^ (((sb >> 9) & 1) << 5); R = (st >> 1) * 16 + swz / 64; C = (st & 1) * 32 + (swz % 64) / 2; }
__host__ __device__ __forceinline__ int perm32(int rho) { const int n = rho >> 4, i = rho & 15; return 8 * (i >> 2) + 4 * n + (i & 3); }

struct Unit { int pm, pn, hm; };
struct Gemm { const bf16_t* A; const bf16_t* Bt; int M, N, K; };

struct StaticOrder {
    int nM, nN, nwg, G, c;
    __host__ __device__ void init(int M, int N, int G_, int c_) { nM = M / BM; nN = N / BM; nwg = nM * nN; G = G_; c = c_; }
    __host__ __device__ bool next(int i, Unit& u) const {
        const int nfull = nwg / G, rem = nwg - nfull * G; long L = (long)i * G + c; int hm = 0;
        if (i >= nfull) {
            if (i > nfull || rem == 0) return false;
            if ((G % NXCD) == 0 && (rem % NXCD) == 0 && 2 * rem <= G) { const int j = c / NXCD; if (j >= 2 * (rem / NXCD)) return false; L = (long)nfull * G + NXCD * (j >> 1) + (c % NXCD); hm = 1 + (j & 1); }
            else if (L >= nwg) return false;
        }
        int wgid = (int)L; { const int q = nwg / NXCD, r = nwg % NXCD, xcd = wgid % NXCD, off = wgid / NXCD; wgid = (xcd < r ? xcd * (q + 1) : r * (q + 1) + (xcd - r) * q) + off; }
        const int nig = WGM * nN, gid = wgid / nig, fm = gid * WGM, gsz = (nM - fm) < WGM ? (nM - fm) : WGM;
        u.pm = fm + ((wgid % nig) % gsz); u.pn = (wgid % nig) / gsz; u.hm = hm; return true;
    }
    __device__ __forceinline__ void a_ready(const Unit&) const {}
    __device__ __forceinline__ void done(const Unit&) const {}
};


#define PG8_GAS __attribute__((address_space(1)))
__device__ __forceinline__ unsigned cvt_pk_bf16(float lo, float hi) { unsigned r; asm volatile("v_cvt_pk_bf16_f32 %0, %1, %2" : "=v"(r) : "v"(lo), "v"(hi)); return r; }
__device__ __forceinline__ u32x4 pack8(const f32x4 a, const f32x4 b) { u32x4 w; w.x = cvt_pk_bf16(a[0], a[1]); w.y = cvt_pk_bf16(a[2], a[3]); w.z = cvt_pk_bf16(b[0], b[1]); w.w = cvt_pk_bf16(b[2], b[3]); return w; }
constexpr float K_EPS = 1e-6f, K_LOG2E = 1.4426950408889634f, K_C2 = 0.125f * 1.4426950408889634f;
__device__ __forceinline__ f32x4 ldg4(const float* p) { return *(const PG8_GAS f32x4*)p; }
__device__ __forceinline__ void stg4(float* p, const f32x4 v) { *(PG8_GAS f32x4*)p = v; }
__device__ __forceinline__ void stg8h(bf16_t* p, const u32x4 v) { *(PG8_GAS u32x4*)p = v; }
__device__ __forceinline__ float row_rstd(const float* SS, int row) {
    const PG8_GAS f32x4* p = (const PG8_GAS f32x4*)(SS + (size_t)row * 16);
    const f32x4 a = (p[0] + p[1]) + (p[2] + p[3]);
    const float s = (a[0] + a[1]) + (a[2] + a[3]);
    return 1.0f / sqrtf(s * (1.0f / 1024.0f) + K_EPS);
}
__device__ __forceinline__ void wave_rstd(const float* SS, const Unit& u, int wr, int lane, int fr, float (&rs)[2][4]) {
    const int rb = u.pm * BM + (u.hm == 2 ? HALF : 0) + wr * 64 + lane;
    const float v0 = row_rstd(SS, rb), v1 = u.hm ? v0 : row_rstd(SS, rb + HALF);
#pragma unroll
    for (int m = 0; m < 4; ++m) { rs[0][m] = __shfl(v0, 16 * m + fr); rs[1][m] = __shfl(v1, 16 * m + fr); }
}
__device__ __forceinline__ float silu_f(float v) { return v * __builtin_amdgcn_rcpf(1.0f + __builtin_amdgcn_exp2f(v * -1.4426950408889634f)); }
__device__ __forceinline__ float logsigmoid_f(float v) { return fminf(v, 0.f) - 0.6931471805599453f * __builtin_amdgcn_logf(1.0f + __builtin_amdgcn_exp2f(fabsf(v) * -1.4426950408889634f)); }

struct EpiResid {
    static constexpr bool PERM = true, AFTER_DRAIN = false;
    const float* xin; float* xout; bf16_t* XA; float* SS;
    const float* gate;
    const float* nsc;
    const float* ngain;
    __device__ __forceinline__ void operator()(const f32x4 (&acc)[2][2][4][2], const Unit& u, int wr, int wc, int fr, int fq) const {
        const int b = u.pm >> 5, colt = u.pn * BM + wc * 32 + 8 * fq;
        f32x4 gv[2][2], gm[2][2];
#pragma unroll
        for (int bj = 0; bj < 2; ++bj)
#pragma unroll
            for (int n = 0; n < 2; ++n) {
                const int c = colt + bj * HALF + 4 * n;
                gv[bj][n] = ldg4(gate + (size_t)b * 6144 + c);
                if (nsc) { const f32x4 s = ldg4(nsc + (size_t)b * 6144 + c), g = ldg4(ngain + c); gm[bj][n] = g * (s + 1.0f); } else gm[bj][n] = (f32x4){0.f, 0.f, 0.f, 0.f};
            }
        const int row0 = u.pm * BM + (u.hm == 2 ? HALF : 0) + wr * 64 + fr, nai = u.hm ? 1 : 2;
        f32x4 xc[2][2], xn[2][2];
#pragma unroll
        for (int bj = 0; bj < 2; ++bj) { const size_t off = (size_t)row0 * 1024 + colt + bj * HALF; xc[bj][0] = ldg4(xin + off); xc[bj][1] = ldg4(xin + off + 4); }
#pragma unroll
        for (int g = 0; g < 8; ++g) if ((g >> 2) < nai) {
            const int ai = g >> 2, m = g & 3, row = row0 + ai * HALF + m * 16;
            if (g < 7) { const int rown = row0 + ((g + 1) >> 2) * HALF + ((g + 1) & 3) * 16;
#pragma unroll
                for (int bj = 0; bj < 2; ++bj) { const size_t off = (size_t)rown * 1024 + colt + bj * HALF; xn[bj][0] = ldg4(xin + off); xn[bj][1] = ldg4(xin + off + 4); } }
            float ssq = 0.f;
#pragma unroll
            for (int bj = 0; bj < 2; ++bj) {
                const size_t off = (size_t)row * 1024 + colt + bj * HALF;
                const f32x4 y0 = xc[bj][0] + gv[bj][0] * acc[ai][bj][m][0], y1 = xc[bj][1] + gv[bj][1] * acc[ai][bj][m][1];
                stg4(xout + off, y0); stg4(xout + off + 4, y1);
                ssq += (y0[0] * y0[0] + y0[1] * y0[1]) + (y0[2] * y0[2] + y0[3] * y0[3]) + (y1[0] * y1[0] + y1[1] * y1[1]) + (y1[2] * y1[2] + y1[3] * y1[3]);
                if (nsc) stg8h(XA + off, pack8(y0 * gm[bj][0], y1 * gm[bj][1]));
            }
            ssq += __shfl_xor(ssq, 16); ssq += __shfl_xor(ssq, 32);
            if (fq == 0) *(PG8_GAS float*)(SS + (size_t)row * 16 + 4 * u.pn + wc) = ssq;
#pragma unroll
            for (int bj = 0; bj < 2; ++bj) { xc[bj][0] = xn[bj][0]; xc[bj][1] = xn[bj][1]; }
        }
    }
};

struct EpiFfnGu {
    static constexpr bool PERM = true, AFTER_DRAIN = false;
    const float* SS; const float* shW  ; bf16_t* H  ;
    __device__ __forceinline__ void operator()(const f32x4 (&acc)[2][2][4][2], const Unit& u, int wr, int wc, int fr, int fq) const {
        const int b = u.pm >> 5, cw = wc * 32 + 8 * fq;
        float rs8[2][4]; wave_rstd(SS, u, wr, fq * 16 + fr, fr, rs8);
        f32x4 sg[2], su[2];
#pragma unroll
        for (int n = 0; n < 2; ++n) { sg[n] = ldg4(shW + (size_t)b * 5632 + u.pn * BM + cw + 4 * n); su[n] = ldg4(shW + (size_t)b * 5632 + u.pn * BM + HALF + cw + 4 * n); }
        const int row0 = u.pm * BM + (u.hm == 2 ? HALF : 0) + wr * 64 + fr, nai = u.hm ? 1 : 2;
#pragma unroll
        for (int ai = 0; ai < 2; ++ai) if (ai < nai)
#pragma unroll
            for (int m = 0; m < 4; ++m) {
                const int row = row0 + ai * HALF + m * 16; const float rs = rs8[ai][m];
                f32x4 hv[2];
#pragma unroll
                for (int n = 0; n < 2; ++n) {
                    const f32x4 g = acc[ai][0][m][n] * rs + sg[n], uu = acc[ai][1][m][n] * rs + su[n];
#pragma unroll
                    for (int j = 0; j < 4; ++j) hv[n][j] = silu_f(g[j]) * uu[j];
                }
                stg8h(H + (size_t)row * 2816 + u.pn * HALF + cw, pack8(hv[0], hv[1]));
            }
    }
};

struct EpiSwaIn {
    static constexpr bool PERM = true, AFTER_DRAIN = false;
    const float* SS; const float* shW  ; const float* ropeC; const float* ropeS;
    bf16_t *Q  , *Kb  , *Vb  ;
    __device__ __forceinline__ void operator()(const f32x4 (&acc)[2][2][4][2], const Unit& u, int wr, int wc, int fr, int fq) const {
        const int b = u.pm >> 5, cw = wc * 32 + 8 * fq;
        float rs8[2][4]; wave_rstd(SS, u, wr, fq * 16 + fr, fr, rs8);
        f32x4 sv[2][2];
#pragma unroll
        for (int bj = 0; bj < 2; ++bj)
#pragma unroll
            for (int n = 0; n < 2; ++n) sv[bj][n] = ldg4(shW + (size_t)b * 5632 + u.pn * BM + bj * HALF + cw + 4 * n);
        const int row0 = u.pm * BM + (u.hm == 2 ? HALF : 0) + wr * 64 + fr, nai = u.hm ? 1 : 2;
        if (u.pn < 5) {
            f32x4 cc[2], sc[2], cn[2], sn[2];
#pragma unroll
            for (int n = 0; n < 2; ++n) { const size_t o = (size_t)(row0 & 8191) * 32 + 8 * fq + 4 * n; cc[n] = ldg4(ropeC + o); sc[n] = ldg4(ropeS + o); }
#pragma unroll
            for (int g = 0; g < 8; ++g) if ((g >> 2) < nai) {
                const int ai = g >> 2, m = g & 3, row = row0 + ai * HALF + m * 16; const float rs = rs8[ai][m];
                if (g < 7) { const int rown = row0 + ((g + 1) >> 2) * HALF + ((g + 1) & 3) * 16;
#pragma unroll
                    for (int n = 0; n < 2; ++n) { const size_t o = (size_t)(rown & 8191) * 32 + 8 * fq + 4 * n; cn[n] = ldg4(ropeC + o); sn[n] = ldg4(ropeS + o); } }
                f32x4 o1[2], o2[2];
#pragma unroll
                for (int n = 0; n < 2; ++n) { const f32x4 v0 = acc[ai][0][m][n] * rs + sv[0][n], v1 = acc[ai][1][m][n] * rs + sv[1][n];
                    o1[n] = v0 * cc[n] - v1 * sc[n]; o2[n] = v1 * cc[n] + v0 * sc[n]; }
                if (u.pn < 4) {
                    bf16_t* dst = Q + (size_t)row * 1024 + (4 * u.pn + wc) * 64 + 8 * fq;
                    stg8h(dst, pack8(o1[0] * K_C2, o1[1] * K_C2)); stg8h(dst + 32, pack8(o2[0] * K_C2, o2[1] * K_C2));
                } else {
                    bf16_t* dst = Kb + (size_t)row * 256 + wc * 64 + 8 * fq;
                    stg8h(dst, pack8(o1[0], o1[1])); stg8h(dst + 32, pack8(o2[0], o2[1]));
                }
#pragma unroll
                for (int n = 0; n < 2; ++n) { cc[n] = cn[n]; sc[n] = sn[n]; }
            }
        } else {
#pragma unroll
            for (int ai = 0; ai < 2; ++ai) if (ai < nai)
#pragma unroll
                for (int m = 0; m < 4; ++m) { const int row = row0 + ai * HALF + m * 16; const float rs = rs8[ai][m];
#pragma unroll
                    for (int bj = 0; bj < 2; ++bj) stg8h(Vb + (size_t)row * 256 + bj * HALF + cw, pack8(acc[ai][bj][m][0] * rs + sv[bj][0], acc[ai][bj][m][1] * rs + sv[bj][1])); }
        }
    }
};

struct EpiFoxIn {
    static constexpr bool PERM = true, AFTER_DRAIN = false;
    const float* SS; const float* shW; bf16_t* Q; size_t tstride;
    int* NRM;
    __device__ __forceinline__ void operator()(const f32x4 (&acc)[2][2][4][2], const Unit& u, int wr, int wc, int fr, int fq) const {
        const int b = u.pm >> 5, cw = wc * 32 + 8 * fq, ty = u.pn >> 2;
        float rs8[2][4]; wave_rstd(SS, u, wr, fq * 16 + fr, fr, rs8);
        f32x4 sv[2][2];
#pragma unroll
        for (int bj = 0; bj < 2; ++bj)
#pragma unroll
            for (int n = 0; n < 2; ++n) sv[bj][n] = ldg4(shW + (size_t)b * 5632 + u.pn * BM + bj * HALF + cw + 4 * n);
        bf16_t* base = Q + (size_t)ty * tstride; const float sc = ty == 0 ? K_C2 : 1.0f;
        const int row0 = u.pm * BM + (u.hm == 2 ? HALF : 0) + wr * 64 + fr, col = (u.pn & 3) * BM + cw, nai = u.hm ? 1 : 2;
        float mx[2] = {0.f, 0.f};
#pragma unroll
        for (int ai = 0; ai < 2; ++ai) if (ai < nai)
#pragma unroll
            for (int m = 0; m < 4; ++m) {
                const int row = row0 + ai * HALF + m * 16; const float rs = rs8[ai][m];
#pragma unroll
                for (int bj = 0; bj < 2; ++bj) {
                    const f32x4 a0 = (acc[ai][bj][m][0] * rs + sv[bj][0]) * sc, a1 = (acc[ai][bj][m][1] * rs + sv[bj][1]) * sc;
                    stg8h(base + (size_t)row * 1024 + col + bj * HALF, pack8(a0, a1));
                    if (ty < 2) { float hs = (a0[0] * a0[0] + a0[1] * a0[1]) + (a0[2] * a0[2] + a0[3] * a0[3]) + (a1[0] * a1[0] + a1[1] * a1[1]) + (a1[2] * a1[2] + a1[3] * a1[3]);
                        hs += __shfl_xor(hs, 16); hs += __shfl_xor(hs, 32);
                        mx[bj] = fmaxf(mx[bj], hs); }
                }
            }
        if (ty < 2) {
#pragma unroll
            for (int bj = 0; bj < 2; ++bj) { float v = mx[bj];
                v = fmaxf(v, __shfl_xor(v, 1)); v = fmaxf(v, __shfl_xor(v, 2)); v = fmaxf(v, __shfl_xor(v, 4)); v = fmaxf(v, __shfl_xor(v, 8));
                if (fr == 0 && fq == 0) atomicMax(NRM + ((ty * 2 + b) * 16 + 4 * (u.pn & 3) + 2 * bj + (wc >> 1)) * 2 + (wc & 1), __float_as_int(v)); }
        }
    }
};

struct EpiGlaIn {
    static constexpr bool PERM = true, AFTER_DRAIN = false;
    const float* SS; const float* shW; const float* bgate  ;
    bf16_t* R0;
    __device__ __forceinline__ void operator()(const f32x4 (&acc)[2][2][4][2], const Unit& u, int wr, int wc, int fr, int fq) const {
        const int b = u.pm >> 5, cw = wc * 32 + 8 * fq, pn = u.pn;
        float rs8[2][4]; wave_rstd(SS, u, wr, fq * 16 + fr, fr, rs8);
        f32x4 sv[2][2];
#pragma unroll
        for (int bj = 0; bj < 2; ++bj)
#pragma unroll
            for (int n = 0; n < 2; ++n) sv[bj][n] = ldg4(shW + (size_t)b * 5632 + pn * BM + bj * HALF + cw + 4 * n);
        const int row0 = u.pm * BM + (u.hm == 2 ? HALF : 0) + wr * 64 + fr, nai = u.hm ? 1 : 2;
        if (pn >= 12) {
            const int col = (pn - 12) * BM + cw;
#pragma unroll
            for (int bj = 0; bj < 2; ++bj)
#pragma unroll
                for (int n = 0; n < 2; ++n) sv[bj][n] += ldg4(bgate + col + bj * HALF + 4 * n);
#pragma unroll
            for (int ai = 0; ai < 2; ++ai) if (ai < nai)
#pragma unroll
                for (int m = 0; m < 4; ++m) {
                    const int row = row0 + ai * HALF + m * 16; const float rs = rs8[ai][m];
#pragma unroll
                    for (int bj = 0; bj < 2; ++bj)
#pragma unroll
                        for (int n = 0; n < 2; ++n) { const f32x4 g = acc[ai][bj][m][n] * rs + sv[bj][n]; f32x4 o;
#pragma unroll
                            for (int j = 0; j < 4; ++j) o[j] = logsigmoid_f(g[j]) * (1.0f / 16.0f);
                            stg4((float*)(R0 + (size_t)48 * 1048576) + (size_t)row * 512 + col + bj * HALF + 4 * n, o); }
                }
            return;
        }
        const bool act = (pn >= 8);
        const int offmib = (pn >= 2 ? 16 : 0) + (pn >= 4 ? 16 : 0) + (pn >= 8 ? 32 : 0);
        const int pitch = pn < 4 ? 512 : 1024; const float sc = pn < 2 ? 0.08838834764831845f : 1.0f;
        const int col = ((pn < 4) ? (pn & 1) : (pn & 3)) * BM + cw;
        bf16_t* base = R0 + (size_t)offmib * 524288;
#pragma unroll
        for (int ai = 0; ai < 2; ++ai) if (ai < nai)
#pragma unroll
            for (int m = 0; m < 4; ++m) {
                const int row = row0 + ai * HALF + m * 16; const float rs = rs8[ai][m];
#pragma unroll
                for (int bj = 0; bj < 2; ++bj) {
                    f32x4 a0 = (acc[ai][bj][m][0] * rs + sv[bj][0]) * sc, a1 = (acc[ai][bj][m][1] * rs + sv[bj][1]) * sc;
                    if (act) {
#pragma unroll
                        for (int j = 0; j < 4; ++j) { a0[j] = silu_f(a0[j]); a1[j] = silu_f(a1[j]); }
                    }
                    stg8h(base + (size_t)row * pitch + col + bj * HALF, pack8(a0, a1));
                }
            }
    }
};
template <class Epi, class Sched, bool ALIGN_EPI = false, bool SP2 = false>
__device__ __forceinline__ void gemm_phase(PG8_LAS unsigned char* lds, const Gemm g, const Sched& S, const Epi& E) {
    int tid_ = threadIdx.x; asm volatile("" : "+v"(tid_));
    const int tid = tid_, wid = __builtin_amdgcn_readfirstlane(tid >> 6), lane = tid & 63, wr = wid >> 2, wc = wid & 3, fr = lane & 15, fq = lane >> 4;
    const int K = g.K, nt = K / BK;
    unsigned voffA[2], voffB[2];
#pragma unroll
    for (int i = 0; i < 2; ++i) { int R, C; stage_rc(tid * 16 + i * 8192, R, C); const int Rb = Epi::PERM ? ((R & ~31) + perm32(R & 31)) : R;
        voffA[i] = (unsigned)(R * K + C) * 2u; voffB[i] = (unsigned)(Rb * K + C) * 2u; }
    const size_t kstep = (size_t)(BK * 2);
    const size_t hstep = (size_t)HALF * K * 2;
    const size_t tstep = 2 * hstep;
    const unsigned ldsw = (unsigned)wid * 1024u;
    const int aoff = lds_byte(wr * 64 + fr, fq * 8), boff = lds_byte(wc * 32 + fr, fq * 8);
#define PG8_SA(b, h) (((b) * 2 + (h)) * HTB)
#define PG8_SB(b, h) ((4 + (b) * 2 + (h)) * HTB)
#define PG8_STAGE(bufoff, gbase, voff) do { _Pragma("unroll") for (int _i = 0; _i < 2; ++_i) \
        __builtin_amdgcn_global_load_lds((const unsigned*)((const char*)(gbase) + (voff)[_i]), (PG8_LAS unsigned*)(lds + (bufoff) + ldsw + _i * 8192), 16, 0, 0); } while (0)
#define PG8_LDA(dst, b, h) do { _Pragma("unroll") for (int m = 0; m < 4; ++m) _Pragma("unroll") for (int k = 0; k < 2; ++k) dst[m][k] = *(const PG8_LAS bf16x8*)(lds + PG8_SA(b, h) + aoff + m * 2048 + k * 1024); } while (0)
#define PG8_LDB(dst, b, h) do { _Pragma("unroll") for (int n = 0; n < 2; ++n) _Pragma("unroll") for (int k = 0; k < 2; ++k) dst[n][k] = *(const PG8_LAS bf16x8*)(lds + PG8_SB(b, h) + boff + n * 2048 + k * 1024); } while (0)
#define PG8_MMA(ai, bj, At, Bt) do { __builtin_amdgcn_s_setprio(1); _Pragma("unroll") for (int m = 0; m < 4; ++m) _Pragma("unroll") for (int n = 0; n < 2; ++n) _Pragma("unroll") for (int k = 0; k < 2; ++k) \
        acc[ai][bj][m][n] = __builtin_amdgcn_mfma_f32_16x16x32_bf16(Bt[n][k], At[m][k], acc[ai][bj][m][n], 0, 0, 0); __builtin_amdgcn_s_setprio(0); } while (0)
#define PG8_WAIT_V(n) asm volatile("s_waitcnt vmcnt(" #n ")" ::: "memory")
#define PG8_WAIT_L(n) asm volatile("s_waitcnt lgkmcnt(" #n ")" ::: "memory")
#define PG8_BAR __builtin_amdgcn_s_barrier()
#define PG8_SCHED __builtin_amdgcn_sched_barrier(0)
    Unit cur, nxt; int ui = 0;
    if (!S.next(0, cur)) return;
    f32x4 acc[2][2][4][2];
#pragma unroll
    for (int a = 0; a < 2; ++a)
#pragma unroll
        for (int b = 0; b < 2; ++b)
#pragma unroll
            for (int m = 0; m < 4; ++m)
#pragma unroll
                for (int n = 0; n < 2; ++n) acc[a][b][m][n] = (f32x4){0.f, 0.f, 0.f, 0.f};
    bf16x8 At[4][2], B0[2][2], B1[2][2];
    const char* cA = (const char*)g.A + (size_t)cur.pm * tstep + (cur.hm == 2 ? hstep : (size_t)0); const char* cB = (const char*)g.Bt + (size_t)cur.pn * tstep;
    S.a_ready(cur);
    if constexpr (SP2) {
        PG8_STAGE(PG8_SB(0, 0), cB, voffB); PG8_STAGE(PG8_SB(0, 1), cB + hstep, voffB); PG8_STAGE(PG8_SA(0, 0), cA, voffA); PG8_STAGE(PG8_SA(0, 1), cA + hstep, voffA);
        if (wr == 1) PG8_BAR;
        PG8_WAIT_V(2); PG8_BAR;
        PG8_STAGE(PG8_SB(1, 0), cB + kstep, voffB); PG8_STAGE(PG8_SA(1, 0), cA + kstep, voffA); PG8_STAGE(PG8_SB(1, 1), cB + hstep + kstep, voffB);
        PG8_WAIT_V(6); PG8_BAR;
    } else {
        PG8_STAGE(PG8_SB(0, 0), cB, voffB); PG8_STAGE(PG8_SA(0, 0), cA, voffA); PG8_STAGE(PG8_SB(0, 1), cB + hstep, voffB); PG8_STAGE(PG8_SA(0, 1), cA + hstep, voffA);
        if (wr == 1) PG8_BAR;
        PG8_WAIT_V(4); PG8_BAR;
        PG8_STAGE(PG8_SB(1, 0), cB + kstep, voffB); PG8_STAGE(PG8_SA(1, 0), cA + kstep, voffA); PG8_STAGE(PG8_SB(1, 1), cB + hstep + kstep, voffB);
        PG8_WAIT_V(6); PG8_BAR;
    }
    for (;;) {
        const bool has_next = S.next(ui + 1, nxt);
        const bool full = (cur.hm == 0);
        const char* nA = has_next ? (const char*)g.A + (size_t)nxt.pm * tstep + (nxt.hm == 2 ? hstep : (size_t)0) : cA; const char* nB = has_next ? (const char*)g.Bt + (size_t)nxt.pn * tstep : cB;
        for (int t = 0; t < nt; t += 2) {
            const bool last = (t == nt - 2);
            const char* a1 = cA + (size_t)(t + 1) * kstep;
            const char* a2 = last ? nA : cA + (size_t)(t + 2) * kstep; const char* b2 = last ? nB : cB + (size_t)(t + 2) * kstep;
            const char* a3 = a2 + kstep; const char* b3 = b2 + kstep;
            if (last && has_next) S.a_ready(nxt);
            if constexpr (SP2) {
            PG8_LDB(B0, 0, 0); PG8_LDB(B1, 0, 1); PG8_SCHED; PG8_LDA(At, 0, 0); PG8_STAGE(PG8_SA(1, 1), a1 + hstep, voffA);
            PG8_WAIT_V(8); PG8_WAIT_L(0); PG8_BAR; PG8_MMA(0, 0, At, B0); PG8_MMA(0, 1, At, B1); PG8_BAR; PG8_SCHED;
            PG8_LDA(At, 0, 1); PG8_STAGE(PG8_SB(0, 0), b2, voffB); PG8_STAGE(PG8_SB(0, 1), b2 + hstep, voffB); PG8_STAGE(PG8_SA(0, 0), a2, voffA);
            PG8_WAIT_V(8); PG8_WAIT_L(0); PG8_BAR; if (full) { PG8_MMA(1, 0, At, B0); PG8_MMA(1, 1, At, B1); } PG8_BAR; PG8_SCHED;
            PG8_LDB(B0, 1, 0); PG8_LDB(B1, 1, 1); PG8_SCHED; PG8_LDA(At, 1, 0); PG8_STAGE(PG8_SA(0, 1), a2 + hstep, voffA);
            PG8_WAIT_V(8); PG8_WAIT_L(0); PG8_BAR; PG8_MMA(0, 0, At, B0); PG8_MMA(0, 1, At, B1); PG8_BAR; PG8_SCHED;
            PG8_LDA(At, 1, 1); PG8_STAGE(PG8_SB(1, 0), b3, voffB); PG8_STAGE(PG8_SB(1, 1), b3 + hstep, voffB); PG8_STAGE(PG8_SA(1, 0), a3, voffA);
            PG8_WAIT_V(8); PG8_WAIT_L(0); PG8_BAR; if (full) { PG8_MMA(1, 0, At, B0); PG8_MMA(1, 1, At, B1); } PG8_BAR; PG8_SCHED;
            } else {
            PG8_LDB(B0, 0, 0); PG8_SCHED; PG8_LDA(At, 0, 0); PG8_STAGE(PG8_SA(1, 1), a1 + hstep, voffA);
            PG8_WAIT_L(8); PG8_BAR; PG8_WAIT_L(0); PG8_MMA(0, 0, At, B0); PG8_BAR; PG8_SCHED;
            PG8_LDB(B1, 0, 1); PG8_STAGE(PG8_SB(0, 0), b2, voffB);
            PG8_BAR; PG8_WAIT_L(0); PG8_MMA(0, 1, At, B1); PG8_BAR;
            PG8_LDA(At, 0, 1); PG8_STAGE(PG8_SA(0, 0), a2, voffA);
            PG8_BAR; PG8_WAIT_L(0); PG8_MMA(1, 0, At, B0); PG8_BAR; PG8_SCHED;
            PG8_STAGE(PG8_SB(0, 1), b2 + hstep, voffB);
            PG8_WAIT_V(6); PG8_BAR; PG8_MMA(1, 1, At, B1); PG8_BAR;
            PG8_LDB(B0, 1, 0); PG8_SCHED; PG8_LDA(At, 1, 0); PG8_STAGE(PG8_SA(0, 1), a2 + hstep, voffA);
            PG8_WAIT_L(8); PG8_BAR; PG8_WAIT_L(0); PG8_MMA(0, 0, At, B0); PG8_BAR; PG8_SCHED;
            PG8_LDB(B1, 1, 1); PG8_STAGE(PG8_SB(1, 0), b3, voffB);
            PG8_BAR; PG8_WAIT_L(0); PG8_MMA(0, 1, At, B1); PG8_BAR;
            PG8_LDA(At, 1, 1); PG8_STAGE(PG8_SA(1, 0), a3, voffA);
            PG8_BAR; PG8_WAIT_L(0); PG8_MMA(1, 0, At, B0); PG8_BAR; PG8_SCHED;
            PG8_STAGE(PG8_SB(1, 1), b3 + hstep, voffB);
            PG8_WAIT_V(6); PG8_BAR; PG8_MMA(1, 1, At, B1); PG8_BAR;
            }
        }
        if constexpr (ALIGN_EPI) { if (wr == 0) PG8_BAR; }
        if constexpr (!Epi::AFTER_DRAIN) { E(acc, cur, wr, wc, fr, fq); S.done(cur); }
        if (!has_next) break;
#pragma unroll
        for (int a = 0; a < 2; ++a)
#pragma unroll
            for (int b = 0; b < 2; ++b)
#pragma unroll
                for (int m = 0; m < 4; ++m)
#pragma unroll
                    for (int n = 0; n < 2; ++n) acc[a][b][m][n] = (f32x4){0.f, 0.f, 0.f, 0.f};
        cur = nxt; cA = nA; cB = nB; ++ui;
        if constexpr (ALIGN_EPI) { if (wr == 1) PG8_BAR; }
    }
    PG8_WAIT_V(0);
    if constexpr (!ALIGN_EPI) { if (wr == 0) PG8_BAR; }
    PG8_BAR;
    if constexpr (Epi::AFTER_DRAIN) { E.fused(acc, cur, wr, wc, fr, fq, lds, wid, lane); S.done(cur); }
#undef PG8_SA
#undef PG8_SB
#undef PG8_STAGE
#undef PG8_LDA
#undef PG8_LDB
#undef PG8_MMA
#undef PG8_WAIT_V
#undef PG8_WAIT_L
#undef PG8_BAR
#undef PG8_SCHED
}
}
#include <hip/hip_bf16.h>
#include <cmath>
namespace attn_body {
using bf16=__hip_bfloat16;
using bf16x8=__attribute__((ext_vector_type(8)))short;
using s16x4=__attribute__((ext_vector_type(4)))short;
using f32x16=__attribute__((ext_vector_type(16)))float;
using u32x4=__attribute__((ext_vector_type(4)))unsigned;
constexpr int BATCH=2,NHEAD=16,SEQ=8192,D=64,DM=NHEAD*D;
constexpr int NW=8,QBLK=32,QB=QBLK*NW,KVBLK=64,NQB=SEQ/QB;
constexpr int ATTN_PITCH=DM, ATTN_UNIT_ROWS=QB;
__device__ __forceinline__ int crow(int r,int hi){return (r&3)+8*(r>>2)+4*hi;}
#define SBAR() __builtin_amdgcn_sched_barrier(0)
__device__ __forceinline__ void cmask(f32x16&p0,f32x16&p1,int jb,int qrel,int hi){
  const float NEG=-INFINITY; int kb=64*jb+4*hi;
  #pragma unroll
  for(int r=0;r<16;++r){int kv=kb+(r&3)+8*(r>>2); if(kv>qrel)p0[r]=NEG; if(kv+32>qrel)p1[r]=NEG;}
}

constexpr int NSLOT=3, SLOTB=8192;
constexpr int LDS_K=0, LDS_V=NSLOT*SLOTB, LDS_WS=2*NSLOT*SLOTB, LDS_OST=LDS_WS+NW*64*4, LDS_BYTES=LDS_OST+NW*4096;
constexpr float C2=0.125f*1.4426950408889634f;
__device__ __forceinline__ void glds16(const void*gsrc,unsigned lds_dst){unsigned keep;
  asm volatile("s_mov_b32 %0, m0\n\ts_mov_b32 m0, %2\n\ts_nop 0\n\tglobal_load_lds_dwordx4 %1, off\n\ts_mov_b32 m0, %0":"=&s"(keep):"v"(gsrc),"s"(lds_dst):"memory");}
__device__ __forceinline__ float max3f(float a,float b,float c){float r;asm("v_max3_f32 %0, %1, %2, %3":"=v"(r):"v"(a),"v"(b),"v"(c));return r;}
__device__ __forceinline__ float max2f(float a,float b){float r;asm("v_max_f32_e32 %0, %1, %2":"=v"(r):"v"(a),"v"(b));return r;}
__device__ __forceinline__ float fadd_s(float a,float b){float r;asm("v_add_f32_e32 %0, %1, %2":"=v"(r):"v"(a),"v"(b));return r;}
__device__ __forceinline__ float fsub_s(float a,float b){float r;asm("v_sub_f32_e32 %0, %1, %2":"=v"(r):"v"(a),"v"(b));return r;}
typedef float f32x2_t __attribute__((ext_vector_type(2))); typedef __bf16 bf16x2_t __attribute__((ext_vector_type(2)));
__device__ __forceinline__ unsigned cvtpk_s(float lo,float hi){f32x2_t v={lo,hi};bf16x2_t b=__builtin_convertvector(v,bf16x2_t);return __builtin_bit_cast(unsigned,b);}
#define WAIT_BAR(N) asm volatile("s_waitcnt vmcnt(" #N ") lgkmcnt(0)\n\ts_barrier":::"memory")

__device__ __forceinline__ void qkt(f32x16&p0,f32x16&p1,const char*Kslot,const bf16x8*qr,const f32x16&c0,const f32x16&c1,int r32,int hi){
  const char*kb=Kslot+hi*1024+r32*16;
  #pragma unroll
  for(int d0=0;d0<4;++d0){
    const bf16x8 b0=*reinterpret_cast<const bf16x8*>(kb+d0*2048);
    const bf16x8 b1=*reinterpret_cast<const bf16x8*>(kb+d0*2048+512);
    if(d0==0){p0=__builtin_amdgcn_mfma_f32_32x32x16_bf16(b0,qr[0],c0,0,0,0);p1=__builtin_amdgcn_mfma_f32_32x32x16_bf16(b1,qr[0],c1,0,0,0);}
    else{p0=__builtin_amdgcn_mfma_f32_32x32x16_bf16(b0,qr[d0],p0,0,0,0);p1=__builtin_amdgcn_mfma_f32_32x32x16_bf16(b1,qr[d0],p1,0,0,0);}}
}
typedef __attribute__((address_space(3))) const char* lds_cptr;
typedef short v4i16_t __attribute__((ext_vector_type(4)));
__device__ __forceinline__ void kload8(bf16x8*kf,lds_cptr kp){
  kf[0]=*(const __attribute__((address_space(3))) bf16x8*)(kp);      kf[1]=*(const __attribute__((address_space(3))) bf16x8*)(kp+512);
  kf[2]=*(const __attribute__((address_space(3))) bf16x8*)(kp+2048); kf[3]=*(const __attribute__((address_space(3))) bf16x8*)(kp+2560);
  kf[4]=*(const __attribute__((address_space(3))) bf16x8*)(kp+4096); kf[5]=*(const __attribute__((address_space(3))) bf16x8*)(kp+4608);
  kf[6]=*(const __attribute__((address_space(3))) bf16x8*)(kp+6144); kf[7]=*(const __attribute__((address_space(3))) bf16x8*)(kp+6656);
}
__device__ __forceinline__ void kload2(bf16x8*kf,lds_cptr kp,int j){ kf[2*j]=*(const __attribute__((address_space(3))) bf16x8*)(kp+j*2048); kf[2*j+1]=*(const __attribute__((address_space(3))) bf16x8*)(kp+j*2048+512); }
__device__ __forceinline__ s16x4 vtr(lds_cptr p){ return __builtin_bit_cast(s16x4,__builtin_amdgcn_ds_read_tr16_b64_v4i16((__attribute__((address_space(3))) v4i16_t*)p)); }
__device__ __forceinline__ float rowmax(const f32x16&p0,const f32x16&p1){
  float a=max3f(p0[0],p0[1],p1[0]),b=max3f(p0[2],p0[3],p1[1]);a=max3f(a,p1[2],p1[3]);
  #pragma unroll
  for(int r=4;r<16;r+=4){a=max3f(a,p0[r],p0[r+1]);b=max3f(b,p0[r+2],p0[r+3]);a=max3f(a,p1[r],p1[r+1]);b=max3f(b,p1[r+2],p1[r+3]);}
  const float m=max2f(a,b);
  auto rr=__builtin_amdgcn_permlane32_swap(__float_as_uint(m),__float_as_uint(m),false,false);
  return max2f(__uint_as_float(rr[0]),__uint_as_float(rr[1]));
}
__device__ __forceinline__ void pv(f32x16*o,int vb,bf16x8 pa0,bf16x8 pa1,bf16x8 pa2,bf16x8 pa3){
  #pragma unroll
  for(int d0=0;d0<2;++d0){s16x4 lo[4],hi[4];
    #pragma unroll
    for(int ks=0;ks<4;++ks){
      asm volatile("ds_read_b64_tr_b16 %0,%1 offset:%c2":"=&v"(lo[ks]):"v"(vb),"i"(d0*4096+ks*1024):"memory");
      asm volatile("ds_read_b64_tr_b16 %0,%1 offset:%c2":"=&v"(hi[ks]):"v"(vb),"i"(d0*4096+ks*1024+512):"memory");}
    asm volatile("s_waitcnt lgkmcnt(0)":::"memory");SBAR();
    #define PK(k) (bf16x8){lo[k][0],lo[k][1],lo[k][2],lo[k][3],hi[k][0],hi[k][1],hi[k][2],hi[k][3]}
    o[d0]=__builtin_amdgcn_mfma_f32_32x32x16_bf16(pa0,PK(0),o[d0],0,0,0);
    o[d0]=__builtin_amdgcn_mfma_f32_32x32x16_bf16(pa1,PK(1),o[d0],0,0,0);
    o[d0]=__builtin_amdgcn_mfma_f32_32x32x16_bf16(pa2,PK(2),o[d0],0,0,0);
    o[d0]=__builtin_amdgcn_mfma_f32_32x32x16_bf16(pa3,PK(3),o[d0],0,0,0);
    #undef PK
  }
}

#ifndef ATTN_STORE16
#define ATTN_STORE16(p,v) (*(u32x4*)(p)=(v))
#endif
typedef __attribute__((address_space(3))) const float* lds_fptr; typedef float f32x4_t __attribute__((ext_vector_type(4)));
#define NBINIT(C0,C1,t) do{ const lds_fptr nbp_=nbl+64*(t)+4*hi; _Pragma("unroll") for(int g_=0;g_<4;++g_){ const f32x4_t a_=*(const __attribute__((address_space(3))) f32x4_t*)(nbp_+8*g_), b_=*(const __attribute__((address_space(3))) f32x4_t*)(nbp_+32+8*g_); \
    _Pragma("unroll") for(int j_=0;j_<4;++j_){ C0[4*g_+j_]=a_[j_]-mhat; C1[4*g_+j_]=b_[j_]-mhat; } } }while(0)
template<int THRL> __device__ __forceinline__ void attn_unit(int b,int h,int qb,const bf16*Q,const bf16*__restrict__ K,const bf16*__restrict__ V,bf16*O,char*shm,lds_fptr nbl0,int jstart){
  int tid_=threadIdx.x; asm volatile("":"+v"(tid_));
  const int tid=tid_,lane=tid&63,r32=lane&31,hi=lane>>5; const int wid=__builtin_amdgcn_readfirstlane(tid>>6);
  const long rowbase=(long)b*SEQ; const int q0=qb*QB;
  const bf16*Qw=Q+(rowbase+q0+wid*QBLK)*DM+h*D;
  const bf16*Kh=K+(rowbase+(long)jstart*KVBLK)*DM+h*D,*Vh=V+(rowbase+(long)jstart*KVBLK)*DM+h*D; const lds_fptr nbl=nbl0+64*jstart;
  const unsigned lds0=(unsigned)(uintptr_t)shm;
  float*wsf=(float*)(shm+LDS_WS)+wid*64;
  const bf16*ksrc=Kh+(long)lane*DM+wid*8;
  const bf16*vsrc=Vh+(long)(16*(wid&3)+(lane>>2))*DM+(wid>>2)*32+(lane&3)*8;
  const unsigned kdst=lds0+LDS_K+wid*1024, vdst=lds0+LDS_V+wid*1024;
  #define DMA_K(t,slot) glds16(ksrc+(long)(t)*KVBLK*DM,(unsigned)__builtin_amdgcn_readfirstlane(kdst+(slot)))
  #define DMA_V(t,slot) glds16(vsrc+(long)(t)*KVBLK*DM,(unsigned)__builtin_amdgcn_readfirstlane(vdst+(slot)))
  const int vb0=(int)(lds0+LDS_V)+((lane>>4)&1)*32+(lane&3)*8+(4*hi+((lane&15)>>2))*64;
  const char*Kbase=shm+LDS_K; bf16x8 kf[8];
  const lds_cptr shm3=(lds_cptr)shm; const lds_cptr kp0=shm3+LDS_K+hi*1024+r32*16; const lds_cptr vp0=shm3+LDS_V+((lane>>4)&1)*32+(lane&3)*8+(4*hi+((lane&15)>>2))*64;
  const int NT=(q0+QB)/KVBLK-jstart;
  DMA_K(0,0);DMA_V(0,0);DMA_K(1,SLOTB);
  bf16x8 qr[4];
  #pragma unroll
  for(int d0=0;d0<4;++d0)qr[d0]=*reinterpret_cast<const bf16x8*>(&Qw[(long)r32*DM+d0*16+hi*8]);
  float mhat=0.f,l_reg=0.f;f32x16 o[2];o[0]=f32x16{};o[1]=f32x16{};
  const int qrel=wid*QBLK+r32;
  #define CMASK(P0,P1,t) do{int jb_=(t)-(NT-4); if(jb_>=0)cmask(P0,P1,jb_,qrel,hi);}while(0)
  bool resc=false;
  #define START(P0,P1) do{ const float rm=rowmax(P0,P1); resc=false; \
    { const float dl=rm; mhat=fadd_s(mhat,dl); \
      _Pragma("unroll") for(int r=0;r<16;++r){P0[r]=fsub_s(P0[r],dl);P1[r]=fsub_s(P1[r],dl);} \
      } \
    _Pragma("unroll") for(int r=0;r<16;++r)P0[r]=__builtin_amdgcn_exp2f(P0[r]); }while(0)
  #define RESC() do{ if(resc){ asm volatile("s_waitcnt lgkmcnt(0)":::"memory"); \
      _Pragma("unroll") for(int d_=0;d_<2;++d_) _Pragma("unroll") for(int r=0;r<16;++r)o[d_][r]*=wsf[crow(r,hi)]; } }while(0)
  f32x16 pA0,pA1,pB0,pB1;
  int sl_prev=0,sl_cur=0,sl_next=SLOTB;
  #define ROT() do{sl_prev=sl_cur;sl_cur=sl_next;sl_next=(sl_next==(NSLOT-1)*SLOTB)?0:sl_next+SLOTB;}while(0)
  DMA_K(2,2*SLOTB);
  WAIT_BAR(3);
  { f32x16 c0_,c1_; NBINIT(c0_,c1_,0); qkt(pA0,pA1,Kbase,qr,c0_,c1_,r32,hi); } asm volatile("s_nop 15\n\ts_nop 7":"+v"(pA0),"+v"(pA1));CMASK(pA0,pA1,0);
  START(pA0,pA1);
  _Pragma("unroll") for(int r=0;r<16;++r)pA1[r]=__builtin_amdgcn_exp2f(pA1[r]);
  WAIT_BAR(0);
  DMA_K(3,0);DMA_V(1,SLOTB);
  ROT();
  kload8(kf,kp0+sl_cur);
  WAIT_BAR(2);
  s16x4 vlo[8],vhi[8]; u32x4 pw0,pw1,pw2,pw3;
  #define PKW(P,B) cvtpk_s(P[B],P[B+1])
  #define PAF(k) __builtin_bit_cast(bf16x8,pw##k)
  #define VFR(i) (bf16x8){vlo[i][0],vlo[i][1],vlo[i][2],vlo[i][3],vhi[i][0],vhi[i][1],vhi[i][2],vhi[i][3]}
  #define PIN(x) asm volatile("":"+v"(x))
  #define MX3(a,b,c) __builtin_fmaxf(__builtin_fmaxf((a),(b)),(c))
  #define GAPA(MF,A0,A1,A2,A3,W0,W1,PW) do{ MF; sacc+=A0; sacc+=A1; sacc+=A2; sacc+=A3; PIN(sacc); W0; W1; PIN(PW); SBAR(); }while(0)
  #define EX(v) __builtin_amdgcn_exp2f(v)
  #define GAPB(MF,X,B) do{ MF; X[B]=EX(X[B]); X[B+1]=EX(X[B+1]); X[B+2]=EX(X[B+2]); X[B+3]=EX(X[B+3]); PIN(X); SBAR(); }while(0)
  #define VRD(i) do{ vlo[i]=vtr(vp_+(((i)>>2)*4096+((i)&3)*1024)); vhi[i]=vtr(vp_+(((i)>>2)*4096+((i)&3)*1024+512)); }while(0)
  #define KRD(G,j) do{ if(G){ kload2(kf,kp0+sl_next,j); SBAR(); } }while(0)
  #define STEP(C0,C1,P0,P1,t,GK,GV,GL) do{ SBAR(); NBINIT(C0,C1,t); PIN(C0); PIN(C1); SBAR(); \
    const lds_cptr vp_=vp0+sl_prev; \
    VRD(0); SBAR(); float sacc=(P0[0]+P0[1]); \
    GAPA(C0=__builtin_amdgcn_mfma_f32_32x32x16_bf16(kf[0],qr[0],C0,0,0,0), P0[2],P0[3],P0[4],P0[5],     pw0[0]=PKW(P0,0), pw0[1]=PKW(P0,2), pw0); \
    VRD(4); SBAR(); GAPA(C1=__builtin_amdgcn_mfma_f32_32x32x16_bf16(kf[1],qr[0],C1,0,0,0), P0[6],P0[7],P0[8],P0[9],     pw0[2]=PKW(P0,4), pw0[3]=PKW(P0,6), pw0); \
    VRD(1); SBAR(); GAPA(C0=__builtin_amdgcn_mfma_f32_32x32x16_bf16(kf[2],qr[1],C0,0,0,0),   P0[10],P0[11],P0[12],P0[13], pw1[0]=PKW(P0,8), pw1[1]=PKW(P0,10), pw1); \
    VRD(5); SBAR(); GAPA(C1=__builtin_amdgcn_mfma_f32_32x32x16_bf16(kf[3],qr[1],C1,0,0,0),   P0[14],P0[15],P1[0],P1[1],   pw1[2]=PKW(P0,12),pw1[3]=PKW(P0,14), pw1); \
    VRD(2); SBAR(); GAPA(C0=__builtin_amdgcn_mfma_f32_32x32x16_bf16(kf[4],qr[2],C0,0,0,0),   P1[2],P1[3],P1[4],P1[5],     pw2[0]=PKW(P1,0), pw2[1]=PKW(P1,2), pw2); \
    VRD(6); SBAR(); GAPA(C1=__builtin_amdgcn_mfma_f32_32x32x16_bf16(kf[5],qr[2],C1,0,0,0),   P1[6],P1[7],P1[8],P1[9],     pw2[2]=PKW(P1,4), pw2[3]=PKW(P1,6), pw2); \
    VRD(3); SBAR(); GAPA(C0=__builtin_amdgcn_mfma_f32_32x32x16_bf16(kf[6],qr[3],C0,0,0,0),   P1[10],P1[11],P1[12],P1[13], pw3[0]=PKW(P1,8), pw3[1]=PKW(P1,10), pw3); \
    VRD(7); SBAR(); GAPA(C1=__builtin_amdgcn_mfma_f32_32x32x16_bf16(kf[7],qr[3],C1,0,0,0),   P1[14],P1[15],0.f,0.f,       pw3[2]=PKW(P1,12),pw3[3]=PKW(P1,14), pw3); \
    l_reg+=sacc; \
    if(GK){DMA_K((t)+3,sl_cur);} if(GV){DMA_V((t)+1,sl_next);} \
    CMASK(C0,C1,t); \
    { float a=MX3(C0[0],C0[1],C1[0]),b=MX3(C0[2],C0[3],C1[1]); a=MX3(a,C1[2],C1[3]); \
      _Pragma("unroll") for(int r=4;r<16;r+=4){a=MX3(a,C0[r],C0[r+1]);b=MX3(b,C0[r+2],C0[r+3]);a=MX3(a,C1[r],C1[r+1]);b=MX3(b,C1[r+2],C1[r+3]);} \
      float rm=__builtin_fmaxf(a,b); { auto rr=__builtin_amdgcn_permlane32_swap(__float_as_uint(rm),__float_as_uint(rm),false,false); rm=__builtin_fmaxf(__uint_as_float(rr[0]),__uint_as_float(rr[1])); } \
      resc=false; \
      if(__builtin_expect(__any(rm>(float)THRL),0)){ const float dl=__builtin_fmaxf(rm,0.f); mhat+=dl; \
        _Pragma("unroll") for(int r=0;r<16;++r){C0[r]-=dl;C1[r]-=dl;} \
        const float f=__builtin_amdgcn_exp2f(-dl); l_reg*=f; if(hi==0)wsf[r32]=f; resc=true; } } \
    SBAR(); \
    GAPB(o[0]=__builtin_amdgcn_mfma_f32_32x32x16_bf16(PAF(0),VFR(0),o[0],0,0,0), C0,0); \
    GAPB(o[1]=__builtin_amdgcn_mfma_f32_32x32x16_bf16(PAF(0),VFR(4),o[1],0,0,0), C0,4); \
    KRD(GL,0); GAPB(o[0]=__builtin_amdgcn_mfma_f32_32x32x16_bf16(PAF(1),VFR(1),o[0],0,0,0), C0,8); \
    KRD(GL,1); GAPB(o[1]=__builtin_amdgcn_mfma_f32_32x32x16_bf16(PAF(1),VFR(5),o[1],0,0,0), C0,12); \
    KRD(GL,2); GAPB(o[0]=__builtin_amdgcn_mfma_f32_32x32x16_bf16(PAF(2),VFR(2),o[0],0,0,0), C1,0); \
    KRD(GL,3); GAPB(o[1]=__builtin_amdgcn_mfma_f32_32x32x16_bf16(PAF(2),VFR(6),o[1],0,0,0), C1,4); \
    GAPB(o[0]=__builtin_amdgcn_mfma_f32_32x32x16_bf16(PAF(3),VFR(3),o[0],0,0,0), C1,8); \
    GAPB(o[1]=__builtin_amdgcn_mfma_f32_32x32x16_bf16(PAF(3),VFR(7),o[1],0,0,0), C1,12); \
    }while(0)
  int t=1;
  #undef CMASK
  #define CMASK(P0,P1,t) do{}while(0)
  for(;t+5<NT;t+=2){
    STEP(pB0,pB1,pA0,pA1,t,true,true,true);     WAIT_BAR(2); RESC(); ROT();
    STEP(pA0,pA1,pB0,pB1,t+1,true,true,true);   WAIT_BAR(2); RESC(); ROT();
  }
  #undef CMASK
  #define CMASK(P0,P1,t) do{int jb_=(t)-(NT-4); if(jb_>=0)cmask(P0,P1,jb_,qrel,hi);}while(0)
  #define ENDW(tt) do{ if((tt)+3<NT){WAIT_BAR(2);} else if((tt)+2<NT){WAIT_BAR(1);} else {WAIT_BAR(0);} }while(0)
  for(;t+1<NT;t+=2){
    STEP(pB0,pB1,pA0,pA1,t,(t+3<NT),(t+1<NT),(t+1<NT));       ENDW(t);   RESC(); ROT();
    STEP(pA0,pA1,pB0,pB1,t+1,(t+4<NT),(t+2<NT),(t+2<NT));     ENDW(t+1); RESC(); ROT();
  }
  STEP(pB0,pB1,pA0,pA1,NT-1,false,false,false); RESC();
  { float sacc=pB0[0]+pB0[1]; _Pragma("unroll") for(int r=2;r<16;++r)sacc+=pB0[r]; _Pragma("unroll") for(int r=0;r<16;++r)sacc+=pB1[r]; l_reg+=sacc;
    pw0=(u32x4){PKW(pB0,0),PKW(pB0,2),PKW(pB0,4),PKW(pB0,6)};pw1=(u32x4){PKW(pB0,8),PKW(pB0,10),PKW(pB0,12),PKW(pB0,14)};pw2=(u32x4){PKW(pB1,0),PKW(pB1,2),PKW(pB1,4),PKW(pB1,6)};pw3=(u32x4){PKW(pB1,8),PKW(pB1,10),PKW(pB1,12),PKW(pB1,14)};
    SBAR(); pv(o,vb0+sl_cur,PAF(0),PAF(1),PAF(2),PAF(3)); }
  #undef PKW
  #undef PAF
  #undef VFR
  #undef PIN
  #undef MX3
  #undef GAPA
  #undef GAPB
  #undef EX
  #undef VRD
  #undef KRD
  #undef STEP
  #undef ENDW
  {auto rr=__builtin_amdgcn_permlane32_swap(__float_as_uint(l_reg),__float_as_uint(l_reg),false,false);l_reg=__uint_as_float(rr[0])+__uint_as_float(rr[1]);}
  if(hi==0)wsf[32+r32]=l_reg;asm volatile("s_waitcnt lgkmcnt(0)":::"memory");
  float rli[16];
  #pragma unroll
  for(int r=0;r<16;++r)rli[r]=__builtin_amdgcn_rcpf(wsf[32+crow(r,hi)]);
  bf16*Ow=O+(rowbase+q0+wid*QBLK)*DM+h*D;
  { bf16*stg=(bf16*)(shm+LDS_OST)+wid*2048;
    #pragma unroll
    for(int r=0;r<16;++r){const int orow=crow(r,hi);
      #pragma unroll
      for(int d0=0;d0<2;++d0)stg[orow*64+d0*32+r32]=__float2bfloat16(o[d0][r]*rli[r]);}
    asm volatile("s_waitcnt lgkmcnt(0)":::"memory");
    #pragma unroll
    for(int i=0;i<4;++i){const int row=i*8+(lane>>3),ch=lane&7; const u32x4 v=*(const u32x4*)(stg+row*64+ch*8); ATTN_STORE16(Ow+(long)row*DM+ch*8,v);} }
  asm volatile("s_waitcnt lgkmcnt(0)\n\ts_barrier":::"memory");
  #undef DMA_K
  #undef DMA_V
  #undef CMASK
  #undef START
  #undef RESC
  #undef ROT
}
constexpr int ATTN_LDS_BYTES=LDS_BYTES;
struct AttnTensors { const bf16* Q; const bf16* K; const bf16* V; bf16* O; };
struct AttnUnit { int bh; int qb; };
struct StaticOrder {
  int vcu;
  __device__ __forceinline__ explicit StaticOrder(int grid,int block):vcu((block%8)*(grid/8)+block/8){}
  __device__ __forceinline__ bool next(int i,AttnUnit&u)const{ if(i>=4)return false; const int s=vcu&7; u.bh=vcu>>3; u.qb=(i==0)?s:(i==1)?15-s:(i==2)?16+s:31-s; return true; }
  __device__ __forceinline__ void a_ready(const AttnUnit&)const{}
  __device__ __forceinline__ void done(const AttnUnit&)const{}
};
template<int THRL=8> __device__ __forceinline__ void fox_phase(char*lds,const AttnTensors&T,const float*LFT,const int*NRM,unsigned*QH,int vcu){
  typedef __attribute__((address_space(3))) float* lds_fw;
  lds_fw nbw=(lds_fw)((__attribute__((address_space(3))) char*)lds+LDS_BYTES);
  int tid=threadIdx.x; asm volatile("":"+v"(tid));
  const int lane=tid&63, wv=tid>>6;
  int bh=(vcu>>3)&31, cur_bh=-1, scanned=0; float U2=0.f;
  for(;;){
    if(tid==0){ const unsigned idx=__hip_atomic_fetch_add(QH+bh*64,1u,__ATOMIC_RELAXED,__HIP_MEMORY_SCOPE_AGENT); ((__attribute__((address_space(3))) volatile int*)(nbw+8192))[15]=(int)idx; }
    asm volatile("s_waitcnt vmcnt(0) lgkmcnt(0)\n\ts_barrier":::"memory");
    const int idx=((__attribute__((address_space(3))) volatile int*)(nbw+8192))[15];
    asm volatile("s_waitcnt lgkmcnt(0)\n\ts_barrier":::"memory");
    if(idx>=32){ if(++scanned>=32)break; bh=(bh+1)&31; continue; }
    const int qb=31-idx;
    if(bh!=cur_bh){ cur_bh=bh;
      const f32x4_t* src=(const f32x4_t*)(LFT+(size_t)bh*SEQ+16*tid); float v[16];
      #pragma unroll
      for(int i=0;i<4;++i){ const f32x4_t x=src[i]; v[4*i]=x[0];v[4*i+1]=x[1];v[4*i+2]=x[2];v[4*i+3]=x[3]; }
      #pragma unroll
      for(int i=1;i<16;++i)v[i]+=v[i-1];
      float inc=v[15];
      #pragma unroll
      for(int o_=1;o_<64;o_<<=1){ const float y=__shfl_up(inc,o_); if(lane>=o_)inc+=y; }
      if(lane==63)nbw[8192+wv]=inc;
      asm volatile("s_waitcnt lgkmcnt(0)\n\ts_barrier":::"memory");
      float pre=inc-v[15];
      #pragma unroll
      for(int w_=0;w_<7;++w_) if(w_<wv)pre+=nbw[8192+w_];
      #pragma unroll
      for(int i=0;i<4;++i){ f32x4_t y; y[0]=-1.4426950408889634f*(pre+v[4*i]); y[1]=-1.4426950408889634f*(pre+v[4*i+1]); y[2]=-1.4426950408889634f*(pre+v[4*i+2]); y[3]=-1.4426950408889634f*(pre+v[4*i+3]);
        *(__attribute__((address_space(3))) f32x4_t*)(nbw+16*tid+4*i)=y; }
      const int b_=bh>>4,h_=bh&15; const int* nq=NRM+((0*2+b_)*16+h_)*2; const int* nk=NRM+((1*2+b_)*16+h_)*2;
      const float qn2=__int_as_float(nq[0])+__int_as_float(nq[1]), kn2=__int_as_float(nk[0])+__int_as_float(nk[1]);
      U2=2.0f*1.03f*sqrtf(qn2*kn2);
      asm volatile("s_waitcnt vmcnt(0) lgkmcnt(0)\n\ts_barrier":::"memory"); }
    int jlo=0,jhi=4*qb; const float ref=nbw[256*qb]-U2-40.0f;
    while(jlo<jhi){ const int mid=(jlo+jhi)>>1; if(nbw[64*mid+63]>=ref)jhi=mid; else jlo=mid+1; }
    const int jstart=__builtin_amdgcn_readfirstlane(jlo&~1);
    attn_unit<THRL>(bh>>4,bh&15,qb,T.Q,T.K,T.V,T.O,lds,(lds_fptr)nbw,jstart);
  }
}
__device__ __forceinline__ void swa_unit(int b,int kvh,int j,const bf16*Q,const bf16*__restrict__ K,const bf16*__restrict__ V,bf16*O,const float*sinks,char*shm){
  int tid_=threadIdx.x; asm volatile("":"+v"(tid_));
  const int tid=tid_,lane=tid&63,r32=lane&31,hi=lane>>5; const int wid=__builtin_amdgcn_readfirstlane(tid>>6);
  const int grp=wid>>1,half=wid&1,qh=kvh*4+grp; const long rowbase=(long)b*SEQ; const int t0=64*j+32*half;
  typedef __attribute__((address_space(3))) char* lds_wptr;
  const lds_wptr shw=(lds_wptr)shm; const lds_cptr shm3=(lds_cptr)shm;
  const unsigned lds0=(unsigned)(uintptr_t)shm;
  float*wsf=(float*)(shm+LDS_WS)+wid*64;
  { const int key=tid>>3,c8=tid&7;
    #pragma unroll
    for(int i=0;i<3;++i){ const int jt=j-2+i; if(jt>=0){
        const long grow=(rowbase+64*jt+key)*256+kvh*64+c8*8;
        const u32x4 kv=*(const u32x4*)(K+grow), vv=*(const u32x4*)(V+grow);
        *(__attribute__((address_space(3))) u32x4*)(shw+LDS_K+i*SLOTB+c8*1024+key*16)=kv;
        *(__attribute__((address_space(3))) u32x4*)(shw+LDS_V+i*SLOTB+(c8>>2)*4096+key*64+(c8&3)*16)=vv; } } }
  const bf16*Qw=Q+(rowbase+t0)*1024+qh*64;
  bf16x8 qr[4];
  #pragma unroll
  for(int d0=0;d0<4;++d0)qr[d0]=*reinterpret_cast<const bf16x8*>(&Qw[(long)r32*1024+d0*16+hi*8]);
  asm volatile("s_waitcnt vmcnt(0) lgkmcnt(0)\n\ts_barrier":::"memory");
  f32x16 p[3][2];
  const lds_cptr kp0=shm3+LDS_K+hi*1024+r32*16;
  #pragma unroll
  for(int i=0;i<3;++i){ const int jt=j-2+i;
    if(jt>=0){ bf16x8 kf[8]; kload8(kf,kp0+i*SLOTB);
      f32x16 c0=f32x16{},c1=f32x16{};
      #pragma unroll
      for(int d0=0;d0<4;++d0){ c0=__builtin_amdgcn_mfma_f32_32x32x16_bf16(kf[2*d0],qr[d0],c0,0,0,0); c1=__builtin_amdgcn_mfma_f32_32x32x16_bf16(kf[2*d0+1],qr[d0],c1,0,0,0); }
      const int dbase=64*(2-i)+32*half+r32-4*hi;
      #pragma unroll
      for(int r=0;r<16;++r){ const int d0_=dbase-((r&3)+8*(r>>2)), d1_=d0_-32;
        p[i][0][r]=(d0_>=0&&d0_<128)?c0[r]:-INFINITY; p[i][1][r]=(d1_>=0&&d1_<128)?c1[r]:-INFINITY; }
    } else {
      #pragma unroll
      for(int r=0;r<16;++r){ p[i][0][r]=-INFINITY; p[i][1][r]=-INFINITY; } } }
  const float sk=sinks[qh]*1.4426950408889634f;
  float m=sk;
  #pragma unroll
  for(int i=0;i<3;++i)
    #pragma unroll
    for(int c=0;c<2;++c)
      #pragma unroll
      for(int r=0;r<16;++r)m=fmaxf(m,p[i][c][r]);
  { auto rr=__builtin_amdgcn_permlane32_swap(__float_as_uint(m),__float_as_uint(m),false,false); m=fmaxf(__uint_as_float(rr[0]),__uint_as_float(rr[1])); }
  float l=0.f;
  #pragma unroll
  for(int i=0;i<3;++i)
    #pragma unroll
    for(int c=0;c<2;++c)
      #pragma unroll
      for(int r=0;r<16;++r){ const float e=__builtin_amdgcn_exp2f(p[i][c][r]-m); p[i][c][r]=e; l+=e; }
  { auto rr=__builtin_amdgcn_permlane32_swap(__float_as_uint(l),__float_as_uint(l),false,false); l=__uint_as_float(rr[0])+__uint_as_float(rr[1]); }
  l+=__builtin_amdgcn_exp2f(sk-m);
  f32x16 o[2]; o[0]=f32x16{}; o[1]=f32x16{};
  const int vb0=(int)(lds0+LDS_V)+((lane>>4)&1)*32+(lane&3)*8+(4*hi+((lane&15)>>2))*64;
  #pragma unroll
  for(int i=0;i<3;++i){ const int jt=j-2+i; if(jt>=0){
      u32x4 w0,w1,w2,w3;
      w0=(u32x4){cvtpk_s(p[i][0][0],p[i][0][1]),cvtpk_s(p[i][0][2],p[i][0][3]),cvtpk_s(p[i][0][4],p[i][0][5]),cvtpk_s(p[i][0][6],p[i][0][7])};
      w1=(u32x4){cvtpk_s(p[i][0][8],p[i][0][9]),cvtpk_s(p[i][0][10],p[i][0][11]),cvtpk_s(p[i][0][12],p[i][0][13]),cvtpk_s(p[i][0][14],p[i][0][15])};
      w2=(u32x4){cvtpk_s(p[i][1][0],p[i][1][1]),cvtpk_s(p[i][1][2],p[i][1][3]),cvtpk_s(p[i][1][4],p[i][1][5]),cvtpk_s(p[i][1][6],p[i][1][7])};
      w3=(u32x4){cvtpk_s(p[i][1][8],p[i][1][9]),cvtpk_s(p[i][1][10],p[i][1][11]),cvtpk_s(p[i][1][12],p[i][1][13]),cvtpk_s(p[i][1][14],p[i][1][15])};
      SBAR(); pv(o,vb0+i*SLOTB,__builtin_bit_cast(bf16x8,w0),__builtin_bit_cast(bf16x8,w1),__builtin_bit_cast(bf16x8,w2),__builtin_bit_cast(bf16x8,w3)); } }
  if(hi==0)wsf[32+r32]=l; asm volatile("s_waitcnt lgkmcnt(0)":::"memory");
  float rli[16];
  #pragma unroll
  for(int r=0;r<16;++r)rli[r]=__builtin_amdgcn_rcpf(wsf[32+crow(r,hi)]);
  bf16*Ow=O+(rowbase+t0)*1024+qh*64;
  { bf16*stg=(bf16*)(shm+LDS_OST)+wid*2048;
    #pragma unroll
    for(int r=0;r<16;++r){const int orow=crow(r,hi);
      #pragma unroll
      for(int d0=0;d0<2;++d0)stg[orow*64+d0*32+r32]=__float2bfloat16(o[d0][r]*rli[r]);}
    asm volatile("s_waitcnt lgkmcnt(0)":::"memory");
    #pragma unroll
    for(int i=0;i<4;++i){const int row=i*8+(lane>>3),ch=lane&7; const u32x4 v=*(const u32x4*)(stg+row*64+ch*8); ATTN_STORE16(Ow+(long)row*1024+ch*8,v);} }
  asm volatile("s_waitcnt lgkmcnt(0)\n\ts_barrier":::"memory");
}
__device__ __forceinline__ void swa_phase(char*lds,const bf16*Q,const bf16*K,const bf16*V,bf16*O,const float*sinks,int grid,int block){
  const int per=(1024+grid-1)/grid;
  for(int i=0;i<per;++i){ const int u=block*per+i; if(u>=1024)break; swa_unit(u>>9,(u>>7)&3,u&127,Q,K,V,O,sinks,lds); }
}
#undef SBAR
#undef WAIT_BAR
}

#define GAS __attribute__((address_space(1)))
#define LAS __attribute__((address_space(3)))
typedef unsigned short bf16;
typedef unsigned v4u __attribute__((ext_vector_type(4)));
typedef float f32x4 __attribute__((ext_vector_type(4)));
typedef short bf16x8 __attribute__((ext_vector_type(8)));
typedef GAS unsigned gu32;
typedef GAS unsigned long long gu64;
#define RLX_AGENT __ATOMIC_RELAXED, __HIP_MEMORY_SCOPE_AGENT
#define LDS_WAIT() asm volatile("s_waitcnt lgkmcnt(0)" ::: "memory")
#define VM_WAIT() asm volatile("s_waitcnt vmcnt(0)" ::: "memory")
__device__ __forceinline__ unsigned long long rt() { return __builtin_amdgcn_s_memrealtime(); }
__device__ __forceinline__ unsigned f2bf(float f) { unsigned u = __builtin_bit_cast(unsigned, f); return (u + 0x7fffu + ((u >> 16) & 1u)) >> 16; }
__device__ __forceinline__ unsigned pk2(float lo, float hi) { return f2bf(lo) | (f2bf(hi) << 16); }

#define XB_TMO      128
#define XB_XCNT(j)  (256  + 64 * (j))
#define XB_XSUB(j)  (1280 + 64 * (j))
#define XB_XGEN(j)  (2304 + 64 * (j))
#define XB_TOP      3328
#define XB_TOPGEN   3392
#define XCD_BAR_WORDS 3456
#define XB_SPIN_CAP (1u << 18)

__device__ __forceinline__ unsigned xb_ld(unsigned* p)              { return __hip_atomic_load(p, __ATOMIC_RELAXED, __HIP_MEMORY_SCOPE_AGENT); }
__device__ __forceinline__ unsigned xb_add(unsigned* p, unsigned v) { return __hip_atomic_fetch_add(p, v, __ATOMIC_RELAXED, __HIP_MEMORY_SCOPE_AGENT); }
__device__ __forceinline__ unsigned xb_xcc_id() { return (unsigned)__builtin_amdgcn_s_getreg((3 << 11) | 20) & 0xFu; }
#define XB_SPIN(cond, bar) do { unsigned _sp = 0; while (cond) { __builtin_amdgcn_s_sleep(1); \
    if ((++_sp & 255u) == 0u) { if (xb_ld(&(bar)[XB_TMO])) break; if (_sp > XB_SPIN_CAP) { atomicAdd(&(bar)[XB_TMO], 1u); break; } } } } while (0)

struct XcdBarrier {
    unsigned* bar; unsigned x;
    volatile LAS unsigned* st;
};

__device__ __forceinline__ XcdBarrier xcd_barrier_post(unsigned* bar, volatile LAS unsigned* st) {
    XcdBarrier b; b.bar = bar; b.x = xb_xcc_id(); b.st = st;
    if (threadIdx.x == 0) (void)xb_add(&bar[XB_XCNT(b.x)], 1u);
    return b;
}
__device__ __forceinline__ void xcd_barrier_complete(unsigned* bar, unsigned x, unsigned& nloc, unsigned& nx) {
    const unsigned G = gridDim.x * gridDim.y * gridDim.z;
    unsigned sum, cnt, mine, sp = 0u;
    for (;;) {
        sum = 0u; cnt = 0u; mine = 0u;
#pragma unroll
        for (unsigned j = 0; j < 16; ++j) { const unsigned c = xb_ld(&bar[XB_XCNT(j)]); sum += c; cnt += (c > 0u) ? 1u : 0u; mine = (j == x) ? c : mine; }
        if (sum == G) break;
        __builtin_amdgcn_s_sleep(1);
        if ((++sp & 255u) == 0u) { if (xb_ld(&bar[XB_TMO])) break; if (sp > XB_SPIN_CAP) { atomicAdd(&bar[XB_TMO], 1u); break; } }
    }
    nloc = mine > 0u ? mine : 1u; nx = cnt > 0u ? cnt : 1u;
}

__device__ __forceinline__ void xcd_barrier(const XcdBarrier& b) {
    asm volatile("s_waitcnt vmcnt(0)" ::: "memory");
    __syncthreads();
    if (threadIdx.x == 0) {
        unsigned* bar = b.bar;
        __builtin_amdgcn_s_waitcnt(0);
        unsigned nloc = b.st[0], nx = b.st[1];
        if (nloc == 0u) { xcd_barrier_complete(bar, b.x, nloc, nx); b.st[0] = nloc; b.st[1] = nx; }
        const unsigned old = xb_add(&bar[XB_XSUB(b.x)], 1u);
        const unsigned gen = old / nloc;
        if (old + 1u == (gen + 1u) * nloc) {
            __builtin_amdgcn_fence(__ATOMIC_RELEASE, "agent");
            asm volatile("s_waitcnt vmcnt(0)" ::: "memory");
            const unsigned og = xb_add(&bar[XB_TOP], 1u);
            const unsigned tg = og / nx;
            if (og + 1u == (tg + 1u) * nx) xb_add(&bar[XB_TOPGEN], 1u);
            else XB_SPIN(xb_ld(&bar[XB_TOPGEN]) == tg, bar);
            __builtin_amdgcn_fence(__ATOMIC_ACQUIRE, "agent");
            xb_add(&bar[XB_XGEN(b.x)], 1u);
            asm volatile("s_waitcnt vmcnt(0)" ::: "memory");
        } else {
            XB_SPIN(xb_ld(&bar[XB_XGEN(b.x)]) == gen, bar);
            __builtin_amdgcn_fence(__ATOMIC_ACQUIRE, "agent");
            asm volatile("s_waitcnt vmcnt(0)" ::: "memory");
        }
    }
    __syncthreads();
}

#ifndef MK_MULTI
#define MK_MULTI 0
#endif
#ifndef PROBE_MASK
#define PROBE_MASK 0
#endif
constexpr int NWAVES = 8;
constexpr int M = 16384, D = 1024, SEQ = 8192, DFF = 2816, NGU = 5632, DEPTH = 4;
constexpr float EPS = 1e-6f, LOG2E = 1.4426950408889634f;
constexpr size_t MiB = 1u << 20;
constexpr size_t WS_CTL = 0, CTL_ZERO_BYTES = 1 * MiB;
constexpr size_t WS_MOD = 512 * 1024;
constexpr size_t WS_SHW = 1 * MiB;
constexpr size_t WS_ROPC = 2 * MiB, WS_ROPS = 3 * MiB;
constexpr size_t WS_SS = 4 * MiB;
constexpr size_t WS_LCL = 5 * MiB;
constexpr size_t WS_BTOT = 6 * MiB;
constexpr size_t WS_EB = 6 * MiB + 512 * 1024;
constexpr size_t WS_W = 8 * MiB;
constexpr size_t W_SWA_IN0 = WS_W, W_SWA_IN1 = WS_W + 3 * MiB, W_SWA_O0 = WS_W + 6 * MiB, W_SWA_O1 = WS_W + 8 * MiB;
constexpr size_t W_GLA_IN = WS_W + 10 * MiB, W_GLA_O = WS_W + 17 * MiB, W_FOX_IN = WS_W + 19 * MiB, W_FOX_O = WS_W + 26 * MiB;
constexpr size_t W_GU0 = WS_W + 28 * MiB, W_GU_STRIDE = 11 * MiB, W_DN0 = WS_W + 72 * MiB, W_DN_STRIDE = 5 * MiB + 512 * 1024;
constexpr size_t WS_XA = 104 * MiB;
constexpr size_t WS_R = 136 * MiB;
constexpr size_t R_H = 0;
constexpr size_t R_SQ = 0, R_SK = 32 * MiB, R_SV = 40 * MiB, R_SO = 48 * MiB;
constexpr size_t R_FQ = 0, R_FK = 32 * MiB, R_FV = 64 * MiB, R_FO = 96 * MiB;
constexpr size_t R_GQ = 0, R_GK = 16 * MiB, R_GV = 32 * MiB, R_GSR = 64 * MiB, R_GLA = 96 * MiB, R_GO = 128 * MiB, R_GA = 160 * MiB, R_GKV = 168 * MiB;
constexpr size_t WS_END = WS_R + 232 * MiB;
static_assert(W_DN0 + 4 * W_DN_STRIDE <= WS_XA && W_GU0 + 4 * W_GU_STRIDE <= W_DN0, "weight map");
constexpr int CW_BAR = 4096;
constexpr int CW_NRM = 8192;
constexpr int CW_QH = 16384;
constexpr int RING_BYTES = 131072, LDS_BYTES = 147456, LDSCTL_OFF = LDS_BYTES - 512, MISC_OFF = LDSCTL_OFF + 320;
constexpr int NPHASES = 25;

struct Args { const float* in[19]; float* out; unsigned char* ws; int ph_lo, ph_hi, li, pad; };

struct Frame {
    LAS unsigned char* lds; volatile LAS unsigned* MISC; gu32* ctl;
    int tid, lane, wave, vcu, G;
};
__device__ __forceinline__ float bf2f(bf16 h) { return __uint_as_float((unsigned)h << 16); }
__device__ __forceinline__ bf16 f2bf16(float f) { return (bf16)f2bf(f); }
__device__ __forceinline__ float rbf(float f) { return bf2f(f2bf16(f)); }
__device__ __forceinline__ float wave_sum(float v) {
#pragma unroll
    for (int o = 1; o < 64; o <<= 1) v += __shfl_xor(v, o);
    return v;
}
__device__ __forceinline__ float wave_max(float v) {
#pragma unroll
    for (int o = 1; o < 64; o <<= 1) v = fmaxf(v, __shfl_xor(v, o));
    return v;
}
__device__ __forceinline__ float silu_d(float v) { return v / (1.0f + __expf(-v)); }
__device__ __forceinline__ float logsig_d(float v) { return fminf(v, 0.f) - log1pf(__expf(-fabsf(v))); }

__device__ __forceinline__ void p0_transpose_item(const float* W, int K, int pitch, bf16* WT, int n0, int lcol0, int k0, LAS float* scr, int lane) {
#pragma unroll 8
    for (int i = 0; i < 32; ++i) { const int kk = 2 * i + (lane >> 5); scr[kk * 33 + (lane & 31)] = W[(size_t)(k0 + kk) * pitch + lcol0 + (lane & 31)]; }
    LDS_WAIT(); asm volatile("" ::: "memory");
    const int c = lane & 7;
#pragma unroll
    for (int j = 0; j < 4; ++j) { const int n = (lane >> 3) + 8 * j; const LAS float* s = scr + (8 * c) * 33 + n;
        v4u o; o.x = pk2(s[0 * 33], s[1 * 33]); o.y = pk2(s[2 * 33], s[3 * 33]); o.z = pk2(s[4 * 33], s[5 * 33]); o.w = pk2(s[6 * 33], s[7 * 33]);
        *(GAS v4u*)(WT + (size_t)(n0 + n) * K + k0 + 8 * c) = o; }
    LDS_WAIT(); asm volatile("" ::: "memory");
}
__device__ __forceinline__ int map_id(int n0) { return n0; }
__device__ __forceinline__ int map_swa(int n0) { const int t = n0 >> 8, p = n0 & 255; return t < 5 ? (t << 8) + (((p >> 5) & 3) << 6) + (((p >> 7) & 1) << 5) : n0; }
__device__ __forceinline__ int map_ffn(int n0) { const int t = n0 >> 8, p = n0 & 255; return p < 128 ? 128 * t + p : 2816 + 128 * t + (p - 128); }

template <int MAP> __device__ __forceinline__ void conv_mat(Frame& F, const float* W, int K, int pitch, bf16* WT, int Nphys, int r) {
    LAS float* scr = (LAS float*)(F.lds + F.wave * 16384);
    const int nblk = Nphys / 32, kb = r / nblk, nb = r % nblk, n0 = nb * 32;
    const int l0 = MAP == 0 ? map_id(n0) : (MAP == 1 ? map_swa(n0) : map_ffn(n0));
    p0_transpose_item(W, K, pitch, WT, n0, l0, kb * 64, scr, F.lane);
}

__device__ __forceinline__ void p0_prologue(Frame& F, const Args& A) {
    unsigned char* ws = A.ws;
    const int gw = F.vcu * NWAVES + F.wave, NGW = F.G * NWAVES;
    constexpr int I_SWA_IN = 16 * (1536 / 32), I_SQ = 16 * (1024 / 32), I_GLA_IN = 16 * (3072 / 32), I_FOX_IN = 16 * (3072 / 32), I_GU = 16 * (5632 / 32), I_DN = 44 * (1024 / 32);
    constexpr int NITEMS = 2 * I_SWA_IN + 4 * I_SQ + I_GLA_IN + I_FOX_IN + 4 * I_GU + 4 * I_DN;
    for (int rep_ = 0; rep_ < (((PROBE_MASK) & 64) ? 2 : 1); ++rep_)
    for (int it = gw; it < NITEMS; it += NGW) {
        int r = it;
        if (r < 4 * I_GU) { const int l = r / I_GU; conv_mat<2>(F, A.in[5] + (size_t)l * 1024 * 5632, 1024, 5632, (bf16*)(ws + W_GU0 + l * W_GU_STRIDE), 5632, r % I_GU); continue; } r -= 4 * I_GU;
        if (r < 4 * I_DN) { const int l = r / I_DN; conv_mat<0>(F, A.in[6] + (size_t)l * 2816 * 1024, 2816, 1024, (bf16*)(ws + W_DN0 + l * W_DN_STRIDE), 1024, r % I_DN); continue; } r -= 4 * I_DN;
        if (r < 2 * I_SWA_IN) { const int j = r / I_SWA_IN; conv_mat<1>(F, A.in[7] + (size_t)j * 1024 * 1536, 1024, 1536, (bf16*)(ws + (j ? W_SWA_IN1 : W_SWA_IN0)), 1536, r % I_SWA_IN); continue; } r -= 2 * I_SWA_IN;
        if (r < 2 * I_SQ) { const int j = r / I_SQ; conv_mat<0>(F, A.in[9] + (size_t)j * 1024 * 1024, 1024, 1024, (bf16*)(ws + (j ? W_SWA_O1 : W_SWA_O0)), 1024, r % I_SQ); continue; } r -= 2 * I_SQ;
        if (r < I_GLA_IN) { conv_mat<0>(F, A.in[10], 1024, 3088, (bf16*)(ws + W_GLA_IN), 3072, r); continue; } r -= I_GLA_IN;
        if (r < I_SQ) { conv_mat<0>(F, A.in[14], 1024, 1024, (bf16*)(ws + W_GLA_O), 1024, r); continue; } r -= I_SQ;
        if (r < I_FOX_IN) { conv_mat<0>(F, A.in[15], 1024, 3088, (bf16*)(ws + W_FOX_IN), 3072, r); continue; } r -= I_FOX_IN;
        conv_mat<0>(F, A.in[17], 1024, 1024, (bf16*)(ws + W_FOX_O), 1024, r);
    }
    const int gt = (F.vcu * NWAVES + F.wave) * 64 + F.lane, NGT = NGW * 64;
    {   const float* win = A.in[10]; const float* wgu = A.in[11]; bf16* WT = (bf16*)(ws + W_GLA_IN);
        for (int i = gt; i < 512 * 1024; i += NGT) { const int j = i >> 10, k = i & 1023; float s = 0.f;
#pragma unroll
            for (int r = 0; r < 16; ++r) s += win[(size_t)k * 3088 + 3072 + r] * wgu[r * 512 + j];
            WT[(size_t)(3072 + j) * 1024 + k] = f2bf16(s); } }
    {   const float* win = A.in[15]; bf16* WT = (bf16*)(ws + W_FOX_IN);
        for (int i = gt; i < 16 * 1024; i += NGT) { const int j = i >> 10, k = i & 1023; WT[(size_t)(3072 + j) * 1024 + k] = f2bf16(win[(size_t)k * 3088 + 3072 + j]); } }
    {   float* rc = (float*)(ws + WS_ROPC); float* rs = (float*)(ws + WS_ROPS);
        for (int i = gt; i < 8192 * 32; i += NGT) { const int pos = i >> 5, d = i & 31; const double inv = exp(-(double)d * (11.918390573078392 / 32.0));
            const double rev = (double)pos * inv * 0.15915494309189535; const float f = (float)(rev - floor(rev));
            rc[i] = __builtin_amdgcn_cosf(f); rs[i] = __builtin_amdgcn_sinf(f); } }
    {   float* mod = (float*)(ws + WS_MOD); const float* c = A.in[1]; const float* aw = A.in[2]; const float* ab = A.in[3];
        for (int task = gw; task < 4 * 24 * 16; task += NGW) {
            const int kc = task & 15, jb = (task >> 4) % 24, l = task / (16 * 24);
            const int j = jb * 256 + F.lane * 4; const float* wp = aw + ((size_t)l * 1024 + kc * 64) * 6144 + j;
            f32x4 a0 = {0.f, 0.f, 0.f, 0.f}, a1 = {0.f, 0.f, 0.f, 0.f};
#pragma unroll 8
            for (int k = 0; k < 64; ++k) { const f32x4 w = *(const f32x4*)(wp + (size_t)k * 6144); const float c0 = silu_d(c[kc * 64 + k]), c1 = silu_d(c[1024 + kc * 64 + k]); a0 += w * c0; a1 += w * c1; }
            if (kc == 0) { const f32x4 bb = *(const f32x4*)(ab + (size_t)l * 6144 + j); a0 += bb; a1 += bb; }
            float* m0 = mod + ((size_t)l * 2 + 0) * 6144 + j; float* m1 = mod + ((size_t)l * 2 + 1) * 6144 + j;
#pragma unroll
            for (int q = 0; q < 4; ++q) { atomicAdd(m0 + q, a0[q]); atomicAdd(m1 + q, a1[q]); }
        } }
}

__device__ __forceinline__ void p1_prologue(Frame& F, const Args& A) {
    unsigned char* ws = A.ws; const float* mod = (const float*)(ws + WS_MOD); float* shw = (float*)(ws + WS_SHW);
    const int gw = F.vcu * NWAVES + F.wave, NGW = F.G * NWAVES, lane = F.lane;
    for (int sub = 0; sub < 8; ++sub) {
        const int l = sub >> 1; const bf16* WT; int nrows;
        if (sub & 1) { WT = (const bf16*)(ws + W_GU0 + l * W_GU_STRIDE); nrows = 5632; }
        else if (l == 0) { WT = (const bf16*)(ws + W_SWA_IN0); nrows = 1536; }
        else if (l == 1) { WT = (const bf16*)(ws + W_GLA_IN); nrows = 3584; }
        else if (l == 2) { WT = (const bf16*)(ws + W_FOX_IN); nrows = 3088; }
        else { WT = (const bf16*)(ws + W_SWA_IN1); nrows = 1536; }
        const float* sh0 = mod + ((size_t)l * 2 + 0) * 6144 + ((sub & 1) ? 3072 : 0); const float* sh1 = sh0 + 6144;
        float s0[16], s1[16];
#pragma unroll
        for (int q = 0; q < 2; ++q)
#pragma unroll
            for (int e = 0; e < 8; ++e) { s0[q * 8 + e] = sh0[q * 512 + lane * 8 + e]; s1[q * 8 + e] = sh1[q * 512 + lane * 8 + e]; }
        for (int n0 = gw * 4; n0 < nrows; n0 += NGW * 4) {
            v4u w[4][2]; float a0[4], a1[4];
#pragma unroll
            for (int r = 0; r < 4; ++r) { const int n = (n0 + r < nrows) ? n0 + r : nrows - 1;
#pragma unroll
                for (int q = 0; q < 2; ++q) w[r][q] = *(const GAS v4u*)(WT + (size_t)n * 1024 + q * 512 + lane * 8); }
#pragma unroll
            for (int r = 0; r < 4; ++r) { a0[r] = 0.f; a1[r] = 0.f;
#pragma unroll
                for (int q = 0; q < 2; ++q) { const unsigned ww[4] = {w[r][q].x, w[r][q].y, w[r][q].z, w[r][q].w};
#pragma unroll
                    for (int e = 0; e < 4; ++e) { const float lo = __uint_as_float(ww[e] << 16), hi = __uint_as_float(ww[e] & 0xffff0000u);
                        a0[r] += lo * s0[q * 8 + 2 * e] + hi * s0[q * 8 + 2 * e + 1]; a1[r] += lo * s1[q * 8 + 2 * e] + hi * s1[q * 8 + 2 * e + 1]; } } }
#pragma unroll
            for (int o = 1; o < 64; o <<= 1) {
#pragma unroll
                for (int r = 0; r < 4; ++r) { a0[r] += __shfl_xor(a0[r], o); a1[r] += __shfl_xor(a1[r], o); } }
            if (lane == 0) {
#pragma unroll
                for (int r = 0; r < 4; ++r) if (n0 + r < nrows) { shw[((size_t)sub * 2 + 0) * 5632 + n0 + r] = a0[r]; shw[((size_t)sub * 2 + 1) * 5632 + n0 + r] = a1[r]; } }
        }
    }
    const float* x = A.in[0]; const float* ng = A.in[4]; bf16* XA = (bf16*)(ws + WS_XA); float* SS = (float*)(ws + WS_SS);
    for (int row = gw; row < M; row += NGW) {
        const int b = row >> 13; const GAS f32x4* xr = (const GAS f32x4*)(x + (size_t)row * D) + lane; const float* sc = mod + (size_t)b * 6144 + 1024;
        float s = 0.f; GAS unsigned long long* o8 = (GAS unsigned long long*)(XA + (size_t)row * D) + lane;
#pragma unroll
        for (int j = 0; j < 4; ++j) { const f32x4 v = xr[64 * j]; s += (v.x * v.x + v.y * v.y) + (v.z * v.z + v.w * v.w);
            const int k = 256 * j + 4 * lane; const f32x4 g = *(const f32x4*)(ng + k), c = *(const f32x4*)(sc + k); const f32x4 y = v * (g * (c + 1.0f));
            o8[64 * j] = (unsigned long long)pk2(y.x, y.y) | ((unsigned long long)pk2(y.z, y.w) << 32); }
        s = wave_sum(s);
        if (lane < 16) SS[(size_t)row * 16 + lane] = lane == 0 ? s : 0.f;
    }
}

__device__ __forceinline__ void final_norm_phase(Frame& F, const Args& A) {
    const int gw = F.vcu * NWAVES + F.wave, NGW = F.G * NWAVES, lane = F.lane; const float* SS = (const float*)(A.ws + WS_SS); const float* fg = A.in[18];
    for (int row = gw; row < M; row += NGW) {
        const float rs = pg8::row_rstd(SS, row); GAS f32x4* xr = (GAS f32x4*)(A.out + (size_t)row * D) + lane;
#pragma unroll
        for (int j = 0; j < 4; ++j) { const f32x4 v = xr[64 * j]; const f32x4 g = *(const f32x4*)(fg + 256 * j + 4 * lane); xr[64 * j] = v * rs * g; }
    }
}

__device__ __forceinline__ void load_row64(const bf16* p, float (&q)[64]) {
#pragma unroll
    for (int i = 0; i < 8; ++i) { const v4u w = *(const GAS v4u*)(p + 8 * i); const unsigned ww[4] = {w.x, w.y, w.z, w.w};
#pragma unroll
        for (int e = 0; e < 4; ++e) { q[8 * i + 2 * e] = __uint_as_float(ww[e] << 16); q[8 * i + 2 * e + 1] = __uint_as_float(ww[e] & 0xffff0000u); } }
}
__device__ __forceinline__ float dot_row64(const bf16* p, const float (&q)[64]) {
    float s = 0.f;
#pragma unroll
    for (int i = 0; i < 8; ++i) { const v4u w = *(const GAS v4u*)(p + 8 * i); const unsigned ww[4] = {w.x, w.y, w.z, w.w};
#pragma unroll
        for (int e = 0; e < 4; ++e) { s += __uint_as_float(ww[e] << 16) * q[8 * i + 2 * e]; s += __uint_as_float(ww[e] & 0xffff0000u) * q[8 * i + 2 * e + 1]; } }
    return s;
}
__device__ __forceinline__ void swa_simple(Frame& F, const bf16* Q, const bf16* Kb, const bf16* Vb, bf16* O, const float* sinks) {
    const int gw = blockIdx.x * NWAVES + F.wave, NGW = F.G * NWAVES, lane = F.lane;
    for (int task = gw; task < M * 16; task += NGW) {
        const int row = task >> 4, h = task & 15, t = row & 8191, rowb = row - t, kvh = h >> 2;
        float q[64]; load_row64(Q + (size_t)row * 1024 + h * 64, q);
        const int s0 = t - lane, s1 = t - 64 - lane;
        const float sc0 = s0 >= 0 ? dot_row64(Kb + (size_t)(rowb + s0) * 256 + kvh * 64, q) : -INFINITY;
        const float sc1 = s1 >= 0 ? dot_row64(Kb + (size_t)(rowb + s1) * 256 + kvh * 64, q) : -INFINITY;
        const float sk = sinks[h] * LOG2E;
        const float m = fmaxf(wave_max(fmaxf(sc0, sc1)), sk);
        const float p0 = exp2f(sc0 - m), p1 = exp2f(sc1 - m);
        const float l = wave_sum(p0 + p1) + exp2f(sk - m);
        float acc = 0.f;
        for (int j = 0; j < 64; ++j) { const int s = t - j; if (s < 0) break; acc += __shfl(p0, j) * bf2f(Vb[(size_t)(rowb + s) * 256 + kvh * 64 + lane]); }
        for (int j = 0; j < 64; ++j) { const int s = t - 64 - j; if (s < 0) break; acc += __shfl(p1, j) * bf2f(Vb[(size_t)(rowb + s) * 256 + kvh * 64 + lane]); }
        O[(size_t)row * 1024 + h * 64 + lane] = f2bf16(acc / l);
    }
}
__device__ __forceinline__ void fox_simple(Frame& F, const bf16* Q, const bf16* Kb, const bf16* Vb, bf16* O, const float* LCL, const float* BTOT) {
    const int gw = blockIdx.x * NWAVES + F.wave, NGW = F.G * NWAVES, lane = F.lane;
    for (int task = gw; task < M * 16; task += NGW) {
        const int row = task >> 4, h = task & 15, t = row & 8191, rowb = row - t, b = row >> 13;
        float q[64]; load_row64(Q + (size_t)row * 1024 + h * 64, q);
        const float bt = lane < 32 ? BTOT[(b * 16 + h) * 32 + lane] : 0.f; float inc = bt;
#pragma unroll
        for (int o = 1; o < 32; o <<= 1) { const float v = __shfl_up(inc, o); if (lane >= o) inc += v; }
        const float excl = inc - bt;
        const float lct = LCL[(size_t)row * 16 + h] + __shfl(excl, t >> 8);
        float m = -1e30f, l = 0.f, o = 0.f;
        for (int c = 0; c <= (t >> 6); ++c) {
            const int s = 64 * c + lane; const bool valid = s <= t; const float base = __shfl(excl, c >> 2);
            float sc = -INFINITY;
            if (valid) sc = dot_row64(Kb + (size_t)(rowb + s) * 1024 + h * 64, q) + LOG2E * (lct - (LCL[(size_t)(rowb + s) * 16 + h] + base));
            const float mn = fmaxf(m, wave_max(sc)); const float alpha = exp2f(m - mn); const float p = exp2f(sc - mn);
            l = l * alpha + wave_sum(p); o *= alpha;
            const int nj = min(64, t - 64 * c + 1);
            for (int j = 0; j < nj; ++j) o += __shfl(p, j) * bf2f(Vb[(size_t)(rowb + 64 * c + j) * 1024 + h * 64 + lane]);
            m = mn;
        }
        O[(size_t)row * 1024 + h * 64 + lane] = f2bf16(o / l);
    }
}
__device__ __forceinline__ void fox_gate_unit(Frame& F, int blk, const bf16* XA, const bf16* Wf  , const float* SS, const float* shWf  , const float* b_f, float* LCL, float* BTOT) {
    LAS bf16* wl = (LAS bf16*)F.lds; LAS float* lf = (LAS float*)(F.lds + 32768); LAS float* seg = (LAS float*)(F.lds + 32768 + 16384);
    const int tid = F.tid, lane = F.lane, wave = F.wave;
    for (int i = tid; i < 16 * 1024 / 8; i += 512) ((LAS v4u*)wl)[i] = ((const GAS v4u*)Wf)[i];
    LDS_WAIT(); __syncthreads();
    const int b = (blk * 256) >> 13;
    for (int r = 0; r < 32; ++r) {
        const int tl = wave * 32 + r, row = blk * 256 + tl;
        float xa[16];
#pragma unroll
        for (int q = 0; q < 2; ++q) { const v4u w = *(const GAS v4u*)(XA + (size_t)row * 1024 + q * 512 + lane * 8); const unsigned ww[4] = {w.x, w.y, w.z, w.w};
#pragma unroll
            for (int e = 0; e < 4; ++e) { xa[q * 8 + 2 * e] = __uint_as_float(ww[e] << 16); xa[q * 8 + 2 * e + 1] = __uint_as_float(ww[e] & 0xffff0000u); } }
        const float rs = pg8::row_rstd(SS, row);
        float mine = 0.f;
#pragma unroll
        for (int h = 0; h < 16; ++h) { float a = 0.f;
#pragma unroll
            for (int q = 0; q < 2; ++q) { const v4u w = *(const LAS v4u*)(wl + h * 1024 + q * 512 + lane * 8); const unsigned ww[4] = {w.x, w.y, w.z, w.w};
#pragma unroll
                for (int e = 0; e < 4; ++e) { a += __uint_as_float(ww[e] << 16) * xa[q * 8 + 2 * e]; a += __uint_as_float(ww[e] & 0xffff0000u) * xa[q * 8 + 2 * e + 1]; } }
            a = wave_sum(a); if (lane == h) mine = a; }
        if (lane < 16) lf[tl * 16 + lane] = logsig_d(mine * rs + shWf[(size_t)b * 5632 + 3072 + lane] + b_f[lane]);
    }
    LDS_WAIT(); __syncthreads();
    const int h = tid & 15, sg = tid >> 4;
    float loc[8]; float run = 0.f;
#pragma unroll
    for (int i = 0; i < 8; ++i) { run += lf[(sg * 8 + i) * 16 + h]; loc[i] = run; }
    seg[sg * 16 + h] = run;
    LDS_WAIT(); __syncthreads();
    float pre = 0.f;
    for (int s2 = 0; s2 < sg; ++s2) pre += seg[s2 * 16 + h];
#pragma unroll
    for (int i = 0; i < 8; ++i) LCL[(size_t)(blk * 256 + sg * 8 + i) * 16 + h] = pre + loc[i];
    if (sg == 31) BTOT[(b * 16 + h) * 32 + (blk & 31)] = pre + run;
    LDS_WAIT(); __syncthreads();
}

__device__ __forceinline__ void gla_A_simple(Frame& F, bf16* Qg, bf16* Kg, const bf16* Vg, const float* LA, float* EB, bf16* Ag, bf16* KV) {
    LAS float* Bc = (LAS float*)F.lds;
    LAS float* Qp = (LAS float*)(F.lds + 32768);
    LAS float* Kp = (LAS float*)(F.lds + 32768 + 33024);
    LAS bf16* Vl = (LAS bf16*)(F.lds + 32768 + 2 * 33024);
    const int tid = F.tid;
    for (int unit = blockIdx.x; unit < 1024; unit += F.G) {
        const int b = unit >> 9, n = (unit >> 2) & 127, h = unit & 3, row0 = b * 8192 + n * 64;
        for (int i = tid; i < 64 * 128; i += 512) { const int t = i >> 7, d = i & 127; Bc[i] = LA[(size_t)(row0 + t) * 512 + h * 128 + d]; }
        for (int i = tid; i < 64 * 256 / 8; i += 512) { const int t = i >> 5, c = i & 31; ((LAS v4u*)Vl)[i] = *(const GAS v4u*)(Vg + (size_t)(row0 + t) * 1024 + h * 256 + c * 8); }
        LDS_WAIT(); __syncthreads();
        if (tid < 128) { float a = 0.f; for (int t = 0; t < 64; ++t) { a += Bc[t * 128 + tid]; Bc[t * 128 + tid] = a; } EB[(size_t)unit * 128 + tid] = __expf(a); }
        LDS_WAIT(); __syncthreads();
        for (int i = tid; i < 64 * 128; i += 512) { const int t = i >> 7, d = i & 127; const float bb = Bc[i]; const size_t g = (size_t)(row0 + t) * 512 + h * 128 + d;
            const bf16 qp = f2bf16(bf2f(Qg[g]) * __expf(bb)), kp = f2bf16(bf2f(Kg[g]) * __expf(-bb));
            Qg[g] = qp; Kg[g] = kp; Qp[t * 129 + d] = bf2f(qp); Kp[t * 129 + d] = bf2f(kp); }
        LDS_WAIT(); __syncthreads();
        {   const int t = tid >> 3, sg = tid & 7;
#pragma unroll
            for (int i = 0; i < 8; ++i) { const int s = sg + 8 * i; float a = 0.f;
                if (s <= t) { for (int d = 0; d < 128; ++d) a += Qp[t * 129 + d] * Kp[s * 129 + d]; }
                Ag[(size_t)unit * 4096 + t * 64 + s] = f2bf16(a); } }
        {   const int d = tid >> 2, eg = tid & 3;
            float acc[64];
#pragma unroll
            for (int i = 0; i < 64; ++i) acc[i] = 0.f;
            for (int s = 0; s < 64; ++s) { const float kp = Kp[s * 129 + d];
#pragma unroll
                for (int i = 0; i < 32; ++i) { const unsigned w = *(const LAS unsigned*)(Vl + s * 256 + eg * 64 + 2 * i); acc[2 * i] += kp * __uint_as_float(w << 16); acc[2 * i + 1] += kp * __uint_as_float(w & 0xffff0000u); } }
            bf16* dst = KV + ((size_t)unit * 128 + d) * 256 + eg * 64;
#pragma unroll
            for (int i = 0; i < 8; ++i) { v4u o; o.x = pk2(acc[8 * i], acc[8 * i + 1]); o.y = pk2(acc[8 * i + 2], acc[8 * i + 3]); o.z = pk2(acc[8 * i + 4], acc[8 * i + 5]); o.w = pk2(acc[8 * i + 6], acc[8 * i + 7]); *(GAS v4u*)(dst + 8 * i) = o; } }
        LDS_WAIT(); __syncthreads();
    }
}
__device__ __forceinline__ void gla_B_scan(Frame& F, bf16* KV, const float* EB) {
    const int idx = blockIdx.x * 512 + F.tid;
    for (int p = idx; p < 131072; p += F.G * 512) {
        const int e2 = p & 127, d = (p >> 7) & 127, h = (p >> 14) & 3, b = p >> 16;
        float s0 = 0.f, s1 = 0.f;
        for (int n0 = 0; n0 < 128; n0 += 16) {
            unsigned kv[16]; float eb[16];
#pragma unroll
            for (int i = 0; i < 16; ++i) { const size_t unit = (size_t)(b * 128 + n0 + i) * 4 + h; kv[i] = *(const GAS unsigned*)(KV + (unit * 128 + d) * 256 + 2 * e2); eb[i] = EB[unit * 128 + d]; }
#pragma unroll
            for (int i = 0; i < 16; ++i) { const size_t unit = (size_t)(b * 128 + n0 + i) * 4 + h;
                *(GAS unsigned*)(KV + (unit * 128 + d) * 256 + 2 * e2) = pk2(s0, s1);
                s0 = eb[i] * (s0 + __uint_as_float(kv[i] << 16)); s1 = eb[i] * (s1 + __uint_as_float(kv[i] & 0xffff0000u)); }
        }
    }
}
__device__ __forceinline__ void gla_C_simple(Frame& F, const bf16* Qg, const bf16* Vg, const bf16* SR, const bf16* Ag, const bf16* Sg, const float* hn, bf16* O) {
    LAS bf16* Sl = (LAS bf16*)F.lds;
    LAS bf16* Vl = (LAS bf16*)(F.lds + 65536);
    LAS float* Al = (LAS float*)(F.lds + 98304);
    LAS float* Ql = (LAS float*)(F.lds + 98304 + 16640);
    LAS bf16* Qb = (LAS bf16*)Ql;
    const int tid = F.tid;
    for (int unit = blockIdx.x; unit < 1024; unit += F.G) {
        const int b = unit >> 9, n = (unit >> 2) & 127, h = unit & 3, row0 = b * 8192 + n * 64;
        for (int i = tid; i < 128 * 256 / 8; i += 512) ((LAS v4u*)Sl)[i] = *(const GAS v4u*)(Sg + (size_t)unit * 32768 + (size_t)i * 8);
        for (int i = tid; i < 64 * 256 / 8; i += 512) { const int t = i >> 5, c = i & 31; ((LAS v4u*)Vl)[i] = *(const GAS v4u*)(Vg + (size_t)(row0 + t) * 1024 + h * 256 + c * 8); }
        for (int i = tid; i < 4096; i += 512) Al[(i >> 6) * 65 + (i & 63)] = bf2f(Ag[(size_t)unit * 4096 + i]);
        for (int i = tid; i < 64 * 128; i += 512) { const int t = i >> 7, d = i & 127; Qb[t * 136 + d] = Qg[(size_t)(row0 + t) * 512 + h * 128 + d]; }
        LDS_WAIT(); __syncthreads();
        const int t = tid >> 3, eg = tid & 7;
        float acc[32];
#pragma unroll
        for (int i = 0; i < 32; ++i) acc[i] = 0.f;
        for (int s = 0; s < 64; ++s) { const float a = Al[t * 65 + s];
#pragma unroll
            for (int i = 0; i < 16; ++i) { const unsigned w = *(const LAS unsigned*)(Vl + s * 256 + eg * 32 + 2 * i); acc[2 * i] += a * __uint_as_float(w << 16); acc[2 * i + 1] += a * __uint_as_float(w & 0xffff0000u); } }
        for (int d = 0; d < 128; ++d) { const float qv = bf2f(Qb[t * 136 + d]);
#pragma unroll
            for (int i = 0; i < 16; ++i) { const unsigned w = *(const LAS unsigned*)(Sl + d * 256 + eg * 32 + 2 * i); acc[2 * i] += qv * __uint_as_float(w << 16); acc[2 * i + 1] += qv * __uint_as_float(w & 0xffff0000u); } }
        float ss = 0.f;
#pragma unroll
        for (int i = 0; i < 32; ++i) ss += acc[i] * acc[i];
        ss += __shfl_xor(ss, 1); ss += __shfl_xor(ss, 2); ss += __shfl_xor(ss, 4);
        const float rs = 1.0f / sqrtf(ss * (1.0f / 256.0f) + EPS);
        const bf16* srp = SR + (size_t)(row0 + t) * 1024 + h * 256 + eg * 32; bf16* op = O + (size_t)(row0 + t) * 1024 + h * 256 + eg * 32;
#pragma unroll
        for (int i = 0; i < 4; ++i) { const v4u w = *(const GAS v4u*)(srp + 8 * i); const unsigned ww[4] = {w.x, w.y, w.z, w.w}; unsigned oo[4];
#pragma unroll
            for (int e = 0; e < 4; ++e) { const int c = 8 * i + 2 * e; const float v0 = acc[c] * rs * hn[eg * 32 + c] * __uint_as_float(ww[e] << 16), v1 = acc[c + 1] * rs * hn[eg * 32 + c + 1] * __uint_as_float(ww[e] & 0xffff0000u); oo[e] = pk2(v0, v1); }
            v4u o; o.x = oo[0]; o.y = oo[1]; o.z = oo[2]; o.w = oo[3]; *(GAS v4u*)(op + 8 * i) = o; }
        LDS_WAIT(); __syncthreads();
    }
}


typedef short s16x4_t __attribute__((ext_vector_type(4)));
typedef float f32x16 __attribute__((ext_vector_type(16)));
__device__ __forceinline__ bf16x8 frag_row(const LAS unsigned char* img, int pitch, int row0, int k0, int lane) {
    return *(const LAS bf16x8*)(img + (row0 + (lane & 31)) * pitch + (k0 + 8 * (lane >> 5)) * 2);
}
__device__ __forceinline__ bf16x8 frag_tr(const LAS unsigned char* img, int pitch, int k0, int col0, int lane) {
    const int g = lane >> 4, i = lane & 15, q = i >> 2, pp = i & 3;
    const LAS unsigned char* a = img + (k0 + 8 * (g >> 1) + q) * pitch + (col0 + 16 * (g & 1) + 4 * pp) * 2;
    const s16x4_t lo = __builtin_bit_cast(s16x4_t, __builtin_amdgcn_ds_read_tr16_b64_v4i16((LAS s16x4_t*)a));
    const s16x4_t hi = __builtin_bit_cast(s16x4_t, __builtin_amdgcn_ds_read_tr16_b64_v4i16((LAS s16x4_t*)(a + 4 * pitch)));
    return (bf16x8){lo[0], lo[1], lo[2], lo[3], hi[0], hi[1], hi[2], hi[3]};
}
__device__ __forceinline__ int crow32(int r, int hi) { return (r & 3) + 8 * (r >> 2) + 4 * hi; }
__device__ __forceinline__ void fox_lf_block(Frame& F, int blk, const bf16* XA, const bf16* Wf  , const float* SS, const float* shWf, const float* b_f, float* LFT) {
    LAS float* Pl = (LAS float*)F.lds;
    const int tid = F.tid, lane = F.lane, wave = F.wave, r32 = lane & 31, hi = lane >> 5, tt = wave & 1, kq = wave >> 1, row0 = blk * 64;
    const bf16* ap = XA + (size_t)(row0 + 32 * tt + r32) * 1024 + 256 * kq + 8 * hi; const bf16* bp = Wf + (size_t)r32 * 1024 + 256 * kq + 8 * hi;
    f32x16 acc = {};
#pragma unroll 4
    for (int ks = 0; ks < 16; ++ks) { const bf16x8 a = *(const GAS bf16x8*)(ap + 16 * ks), bfr = *(const GAS bf16x8*)(bp + 16 * ks); acc = __builtin_amdgcn_mfma_f32_32x32x16_bf16(a, bfr, acc, 0, 0, 0); }
    if (r32 < 16) {
#pragma unroll
        for (int r = 0; r < 16; ++r) Pl[(kq * 64 + 32 * tt + crow32(r, hi)) * 16 + r32] = acc[r];
    }
    LDS_WAIT(); __syncthreads();
    {   const int t = tid >> 3, h0 = 2 * (tid & 7), row = row0 + t, b = row >> 13; const float rs = pg8::row_rstd(SS, row);
#pragma unroll
        for (int z = 0; z < 2; ++z) { const int h = h0 + z; const float s = (Pl[(0 * 64 + t) * 16 + h] + Pl[(1 * 64 + t) * 16 + h]) + (Pl[(2 * 64 + t) * 16 + h] + Pl[(3 * 64 + t) * 16 + h]);
            LFT[((size_t)(b * 16 + h)) * 8192 + (row & 8191)] = logsig_d(s * rs + shWf[(size_t)b * 5632 + 3072 + h] + b_f[h]); } }
    LDS_WAIT(); __syncthreads();
}
constexpr int GP_Q = 272, GP_V = 576, GP_A = 144, GP_ST = 1040;

__device__ __forceinline__ void gla_A_mfma(Frame& F, bf16* Qg, const bf16* Kg, const bf16* Vg, const float* LA, float* EB, bf16* Ag, bf16* KV) {
    LAS float* Bc = (LAS float*)F.lds;
    LAS float* Tot = (LAS float*)(F.lds + 32768);
    LAS unsigned char* Qi = F.lds + 34816;
    LAS unsigned char* Ki = F.lds + 34816 + 17408;
    LAS unsigned char* Vi = F.lds + 34816 + 2 * 17408;
    const int tid = F.tid, lane = F.lane, wave = F.wave;
    for (int unit = blockIdx.x; unit < 1024; unit += F.G) {
        const int b = unit >> 9, n = (unit >> 2) & 127, h = unit & 3, row0 = b * 8192 + n * 64;
        for (int i = tid; i < 64 * 32; i += 512) { const int t = i >> 5, c = i & 31; *(LAS f32x4*)(Bc + t * 128 + c * 4) = *(const GAS f32x4*)(LA + (size_t)(row0 + t) * 512 + h * 128 + c * 4); }
        for (int i = tid; i < 64 * 32; i += 512) { const int t = i >> 5, c = i & 31; *(LAS v4u*)(Vi + t * GP_V + c * 16) = *(const GAS v4u*)(Vg + (size_t)(row0 + t) * 1024 + h * 256 + c * 8); }
        LDS_WAIT(); __syncthreads();
        {   const int d = tid & 127, sg = tid >> 7; float a = 0.f;
#pragma unroll
            for (int t = 0; t < 16; ++t) { a += Bc[(sg * 16 + t) * 128 + d]; Bc[(sg * 16 + t) * 128 + d] = a; }
            Tot[sg * 128 + d] = a; }
        LDS_WAIT(); __syncthreads();
        if (tid < 128) EB[(size_t)unit * 128 + tid] = __expf(Tot[tid] + Tot[128 + tid] + Tot[256 + tid] + Tot[384 + tid]);
        for (int i = tid; i < 64 * 16; i += 512) { const int t = i >> 4, c = i & 15, sg = t >> 4; const size_t g = (size_t)(row0 + t) * 512 + h * 128 + c * 8;
            const v4u qv = *(const GAS v4u*)(Qg + g), kv = *(const GAS v4u*)(Kg + g); const unsigned qq[4] = {qv.x, qv.y, qv.z, qv.w}, kk[4] = {kv.x, kv.y, kv.z, kv.w}; unsigned qo[4], ko[4];
#pragma unroll
            for (int e = 0; e < 4; ++e) { float bb[2];
#pragma unroll
                for (int z = 0; z < 2; ++z) { const int d = c * 8 + 2 * e + z; float v = Bc[t * 128 + d]; if (sg > 0) v += Tot[d]; if (sg > 1) v += Tot[128 + d]; if (sg > 2) v += Tot[256 + d]; bb[z] = v; }
                const float e0 = __expf(bb[0]), e1 = __expf(bb[1]);
                qo[e] = pk2(__uint_as_float(qq[e] << 16) * e0, __uint_as_float(qq[e] & 0xffff0000u) * e1);
                ko[e] = pk2(__uint_as_float(kk[e] << 16) / e0, __uint_as_float(kk[e] & 0xffff0000u) / e1); }
            v4u qw; qw.x = qo[0]; qw.y = qo[1]; qw.z = qo[2]; qw.w = qo[3]; v4u kw; kw.x = ko[0]; kw.y = ko[1]; kw.z = ko[2]; kw.w = ko[3];
            *(GAS v4u*)(Qg + g) = qw; *(LAS v4u*)(Qi + t * GP_Q + c * 16) = qw; *(LAS v4u*)(Ki + t * GP_Q + c * 16) = kw; }
        LDS_WAIT(); __syncthreads();
        const int r32 = lane & 31, hi = lane >> 5;
        if (wave < 4) {
            const int tt = wave & 1, st = wave >> 1; f32x16 acc = {};
            if (st <= tt) {
#pragma unroll
                for (int ks = 0; ks < 8; ++ks) acc = __builtin_amdgcn_mfma_f32_32x32x16_bf16(frag_row(Qi, GP_Q, 32 * tt, 16 * ks, lane), frag_row(Ki, GP_Q, 32 * st, 16 * ks, lane), acc, 0, 0, 0);
            }
            bf16* dst = Ag + (size_t)unit * 4096 + 32 * st + r32;
#pragma unroll
            for (int r = 0; r < 16; ++r) { const int t = 32 * tt + crow32(r, hi), s = 32 * st + r32; dst[t * 64] = f2bf16(s <= t ? acc[r] : 0.f); }
        }
        {   const int dt = wave & 3, eb0 = (wave >> 2) * 4;
            f32x16 acc[4] = {};
#pragma unroll
            for (int ks = 0; ks < 4; ++ks) { const bf16x8 a = frag_tr(Ki, GP_Q, 16 * ks, 32 * dt, lane);
#pragma unroll
                for (int j = 0; j < 4; ++j) acc[j] = __builtin_amdgcn_mfma_f32_32x32x16_bf16(a, frag_tr(Vi, GP_V, 16 * ks, 32 * (eb0 + j), lane), acc[j], 0, 0, 0); }
            bf16* dst = KV + ((size_t)unit * 128 + 32 * dt) * 256 + r32;
#pragma unroll
            for (int j = 0; j < 4; ++j)
#pragma unroll
                for (int r = 0; r < 16; ++r) dst[(size_t)crow32(r, hi) * 256 + 32 * (eb0 + j)] = f2bf16(acc[j][r]);
        }
        LDS_WAIT(); __syncthreads();
    }
}
__device__ __forceinline__ void gla_C_mfma(Frame& F, const bf16* Qg, const bf16* Vg, const bf16* SR, const bf16* Ag, const bf16* Sg, const float* hn, bf16* O) {
    LAS unsigned char* Si = F.lds;
    LAS unsigned char* Vi = F.lds + 73728;
    LAS unsigned char* Ai = F.lds + 73728 + 36864;
    LAS unsigned char* Qi = F.lds + 73728 + 36864 + 9216;
    const int tid = F.tid, lane = F.lane, wave = F.wave;
    for (int unit = blockIdx.x; unit < 1024; unit += F.G) {
        const int b = unit >> 9, n = (unit >> 2) & 127, h = unit & 3, row0 = b * 8192 + n * 64;
        for (int i = tid; i < 128 * 32; i += 512) { const int d = i >> 5, c = i & 31; *(LAS v4u*)(Si + d * GP_V + c * 16) = *(const GAS v4u*)(Sg + (size_t)unit * 32768 + d * 256 + c * 8); }
        for (int i = tid; i < 64 * 32; i += 512) { const int t = i >> 5, c = i & 31; *(LAS v4u*)(Vi + t * GP_V + c * 16) = *(const GAS v4u*)(Vg + (size_t)(row0 + t) * 1024 + h * 256 + c * 8); }
        { const int t = tid >> 3, c = tid & 7; *(LAS v4u*)(Ai + t * GP_A + c * 16) = *(const GAS v4u*)(Ag + (size_t)unit * 4096 + t * 64 + c * 8); }
        for (int i = tid; i < 64 * 16; i += 512) { const int t = i >> 4, c = i & 15; *(LAS v4u*)(Qi + t * GP_Q + c * 16) = *(const GAS v4u*)(Qg + (size_t)(row0 + t) * 512 + h * 128 + c * 8); }
        LDS_WAIT(); __syncthreads();
        const int tt = wave & 1, et0 = (wave >> 1) * 2, r32 = lane & 31, hi = lane >> 5;
        f32x16 acc[2] = {};
#pragma unroll
        for (int ks = 0; ks < 4; ++ks) { const bf16x8 a = frag_row(Ai, GP_A, 32 * tt, 16 * ks, lane);
#pragma unroll
            for (int j = 0; j < 2; ++j) acc[j] = __builtin_amdgcn_mfma_f32_32x32x16_bf16(a, frag_tr(Vi, GP_V, 16 * ks, 32 * (et0 + j), lane), acc[j], 0, 0, 0); }
#pragma unroll
        for (int ks = 0; ks < 8; ++ks) { const bf16x8 a = frag_row(Qi, GP_Q, 32 * tt, 16 * ks, lane);
#pragma unroll
            for (int j = 0; j < 2; ++j) acc[j] = __builtin_amdgcn_mfma_f32_32x32x16_bf16(a, frag_tr(Si, GP_V, 16 * ks, 32 * (et0 + j), lane), acc[j], 0, 0, 0); }
        LDS_WAIT(); __syncthreads();
        LAS float* St = (LAS float*)Si;
#pragma unroll
        for (int j = 0; j < 2; ++j)
#pragma unroll
            for (int r = 0; r < 16; ++r) St[(32 * tt + crow32(r, hi)) * (GP_ST / 4) + 32 * (et0 + j) + r32] = acc[j][r];
        LDS_WAIT(); __syncthreads();
        {   const int t = tid >> 3, eg = tid & 7; float a[32];
#pragma unroll
            for (int i = 0; i < 8; ++i) { const f32x4 v = *(const LAS f32x4*)(St + t * (GP_ST / 4) + eg * 32 + 4 * i); a[4 * i] = v.x; a[4 * i + 1] = v.y; a[4 * i + 2] = v.z; a[4 * i + 3] = v.w; }
            float ss = 0.f;
#pragma unroll
            for (int i = 0; i < 32; ++i) ss += a[i] * a[i];
            ss += __shfl_xor(ss, 1); ss += __shfl_xor(ss, 2); ss += __shfl_xor(ss, 4);
            const float rs = 1.0f / sqrtf(ss * (1.0f / 256.0f) + EPS);
            const bf16* srp = SR + (size_t)(row0 + t) * 1024 + h * 256 + eg * 32; bf16* op = O + (size_t)(row0 + t) * 1024 + h * 256 + eg * 32;
#pragma unroll
            for (int i = 0; i < 4; ++i) { const v4u w = *(const GAS v4u*)(srp + 8 * i); const unsigned ww[4] = {w.x, w.y, w.z, w.w}; unsigned oo[4];
#pragma unroll
                for (int e = 0; e < 4; ++e) { const int c = 8 * i + 2 * e; const float v0 = a[c] * rs * hn[eg * 32 + c] * __uint_as_float(ww[e] << 16), v1 = a[c + 1] * rs * hn[eg * 32 + c + 1] * __uint_as_float(ww[e] & 0xffff0000u); oo[e] = pk2(v0, v1); }
                v4u o; o.x = oo[0]; o.y = oo[1]; o.z = oo[2]; o.w = oo[3]; *(GAS v4u*)(op + 8 * i) = o; } }
        LDS_WAIT(); __syncthreads();
    }
}

__device__ __forceinline__ Frame make_frame(unsigned char* lds_generic) {
    Frame F; int t = threadIdx.x; asm volatile("" : "+v"(t));
    F.lds = (LAS unsigned char*)lds_generic; F.MISC = (volatile LAS unsigned*)(F.lds + MISC_OFF);
    F.tid = t; F.lane = t & 63; F.wave = __builtin_amdgcn_readfirstlane(t >> 6);
    F.G = gridDim.x; { const int bx = blockIdx.x; F.vcu = (F.G % 8 == 0) ? (bx % 8) * (F.G / 8) + bx / 8 : bx; }
    F.ctl = nullptr;
    return F;
}
__global__ void __launch_bounds__(NWAVES * 64, 2) skel_fwd(Args args) {
    extern __shared__ __attribute__((aligned(16))) unsigned char lds[];
    {   LAS unsigned char* l3 = (LAS unsigned char*)lds;
        for (int u = threadIdx.x; u < (LDS_BYTES - LDSCTL_OFF) / 4; u += NWAVES * 64) ((LAS unsigned*)(l3 + LDSCTL_OFF))[u] = 0u;
        __syncthreads(); }
#if !MK_MULTI
    XcdBarrier bar = xcd_barrier_post((unsigned*)((gu32*)(args.ws + WS_CTL) + CW_BAR), (volatile LAS unsigned*)((LAS unsigned char*)lds + MISC_OFF) + 8);
#endif
    const int lo = args.ph_lo, hi = args.ph_hi; int ph = 0;
#define PH_ON (ph >= lo && ph < hi)
#if MK_MULTI
#define PH_BEGINC(cls) if (PH_ON) { { Frame F = make_frame(lds); unsigned char* ws = args.ws; asm volatile("" : "+s"(ws)); int l = lraw; asm volatile("" : "+s"(l)); (void)F; (void)l;
#define PH_END } } ++ph;
#else
#define PH_BEGINC(cls) if (PH_ON) { for (int rep_ = 0; rep_ < (((PROBE_MASK) & (cls)) ? 2 : 1); ++rep_) { if (rep_) xcd_barrier(bar); Frame F = make_frame(lds); unsigned char* ws = args.ws; asm volatile("" : "+s"(ws)); int l = lraw; asm volatile("" : "+s"(l)); (void)F; (void)l;
#define PH_END } } if (PH_ON && (ph + 1) < hi) xcd_barrier(bar); ++ph;
#endif
#define PH_BEGIN PH_BEGINC(0)
#define P_MOD ((const float*)(ws + WS_MOD))
#define P_SS ((float*)(ws + WS_SS))
#define P_SHW(sub) ((const float*)(ws + WS_SHW) + (size_t)(sub) * 2 * 5632)
#define P_XA ((bf16*)(ws + WS_XA))
#define P_R (ws + WS_R)
    int lraw = 0;
    PH_BEGIN p0_prologue(F, args); PH_END
    PH_BEGINC(32) p1_prologue(F, args); PH_END

    for (lraw = 0; lraw < DEPTH; ++lraw) {
        const int kind = lraw % 3;
        if (kind == 0) {
            PH_BEGINC(1)
                const int j = l / 3;
                pg8::Gemm g{P_XA, (const bf16*)(ws + (j ? W_SWA_IN1 : W_SWA_IN0)), M, 1536, 1024}; pg8::StaticOrder S; S.init(M, 1536, F.G, (int)blockIdx.x);
                pg8::EpiSwaIn E{P_SS, P_SHW(2 * l), (const float*)(ws + WS_ROPC), (const float*)(ws + WS_ROPS), (bf16*)(P_R + R_SQ), (bf16*)(P_R + R_SK), (bf16*)(P_R + R_SV)};
                pg8::gemm_phase<pg8::EpiSwaIn, pg8::StaticOrder, true, true>(F.lds, g, S, E);
            PH_END
            PH_BEGINC(4)
                attn_body::swa_phase((char*)lds, (const attn_body::bf16*)(P_R + R_SQ), (const attn_body::bf16*)(P_R + R_SK), (const attn_body::bf16*)(P_R + R_SV), (attn_body::bf16*)(P_R + R_SO), args.in[8] + (l / 3) * 16, (int)F.G, (int)blockIdx.x);
            PH_END
        } else if (kind == 1) {
            PH_BEGINC(1)
                pg8::Gemm g{P_XA, (const bf16*)(ws + W_GLA_IN), M, 3584, 1024}; pg8::StaticOrder S; S.init(M, 3584, F.G, (int)blockIdx.x);
                pg8::EpiGlaIn E{P_SS, P_SHW(2 * l), args.in[12], (bf16*)P_R};
                static_assert(R_GQ == 0 && R_GK == 16 * MiB && R_GV == 32 * MiB && R_GSR == 64 * MiB && R_GLA == 96 * MiB, "EpiGlaIn offsets");
                pg8::gemm_phase<pg8::EpiGlaIn, pg8::StaticOrder, true, true>(F.lds, g, S, E);
            PH_END
            PH_BEGIN
                gla_A_mfma(F, (bf16*)(P_R + R_GQ), (const bf16*)(P_R + R_GK), (const bf16*)(P_R + R_GV), (const float*)(P_R + R_GLA), (float*)(ws + WS_EB), (bf16*)(P_R + R_GA), (bf16*)(P_R + R_GKV));
            PH_END
            PH_BEGIN
                gla_B_scan(F, (bf16*)(P_R + R_GKV), (const float*)(ws + WS_EB));
            PH_END
            PH_BEGINC(16)
                gla_C_mfma(F, (const bf16*)(P_R + R_GQ), (const bf16*)(P_R + R_GV), (const bf16*)(P_R + R_GSR), (const bf16*)(P_R + R_GA), (const bf16*)(P_R + R_GKV), args.in[13], (bf16*)(P_R + R_GO));
            PH_END
        } else {
            PH_BEGINC(1)
                pg8::Gemm g{P_XA, (const bf16*)(ws + W_FOX_IN), M, 3072, 1024}; pg8::StaticOrder S; S.init(M, 3072, F.G, (int)blockIdx.x);
                pg8::EpiFoxIn E{P_SS, P_SHW(2 * l), (bf16*)(P_R + R_FQ), (size_t)(R_FK - R_FQ) / 2, (int*)((gu32*)(ws + WS_CTL) + CW_NRM)};
                static_assert(R_FV - R_FK == R_FK - R_FQ, "EpiFoxIn stride");
                pg8::gemm_phase<pg8::EpiFoxIn, pg8::StaticOrder, true, true>(F.lds, g, S, E);
                for (int blk = blockIdx.x; blk < M / 64; blk += F.G)
                    fox_lf_block(F, blk, P_XA, (const bf16*)(ws + W_FOX_IN) + (size_t)3072 * 1024, P_SS, P_SHW(2 * l), args.in[16], (float*)(ws + WS_LCL));
            PH_END
            PH_BEGINC(8)
                static_assert(attn_body::ATTN_LDS_BYTES + 32768 + 128 <= LDSCTL_OFF && attn_body::ATTN_PITCH == D, "attention body geometry vs frame");
                const attn_body::AttnTensors AT{(const attn_body::bf16*)(P_R + R_FQ), (const attn_body::bf16*)(P_R + R_FK), (const attn_body::bf16*)(P_R + R_FV), (attn_body::bf16*)(P_R + R_FO)};
                attn_body::fox_phase<30>((char*)lds, AT, (const float*)(ws + WS_LCL), (const int*)((gu32*)(ws + WS_CTL) + CW_NRM), (unsigned*)((gu32*)(ws + WS_CTL) + CW_QH) + rep_ * 4096, F.vcu);
            PH_END
        }
        PH_BEGIN
            const int kd = l % 3; const float* modl = P_MOD + (size_t)l * 2 * 6144;
            const bf16* Omix = (const bf16*)(P_R + (kd == 0 ? R_SO : (kd == 1 ? R_GO : R_FO)));
            const bf16* Wo = (const bf16*)(ws + (kd == 0 ? (l ? W_SWA_O1 : W_SWA_O0) : (kd == 1 ? W_GLA_O : W_FOX_O)));
            pg8::Gemm g{Omix, Wo, M, 1024, 1024}; pg8::StaticOrder S; S.init(M, 1024, F.G, (int)blockIdx.x);
            pg8::EpiResid E{l == 0 ? args.in[0] : (const float*)args.out, args.out, P_XA, P_SS, modl + 2048, modl + 4096, args.in[4] + (size_t)(2 * l + 1) * 1024};
            pg8::gemm_phase<pg8::EpiResid, pg8::StaticOrder, false, true>(F.lds, g, S, E);
        PH_END
        PH_BEGINC(2)
            pg8::Gemm g{P_XA, (const bf16*)(ws + W_GU0 + l * W_GU_STRIDE), M, NGU, 1024}; pg8::StaticOrder S; S.init(M, NGU, F.G, (int)blockIdx.x);
            pg8::EpiFfnGu E{P_SS, P_SHW(2 * l + 1), (bf16*)(P_R + R_H)};
            pg8::gemm_phase<pg8::EpiFfnGu, pg8::StaticOrder, true, true>(F.lds, g, S, E);
        PH_END
        PH_BEGIN
            const float* modl = P_MOD + (size_t)l * 2 * 6144; const bool last = (l == DEPTH - 1);
            pg8::Gemm g{(const bf16*)(P_R + R_H), (const bf16*)(ws + W_DN0 + l * W_DN_STRIDE), M, 1024, DFF}; pg8::StaticOrder S; S.init(M, 1024, F.G, (int)blockIdx.x);
            pg8::EpiResid E{args.out, args.out, P_XA, P_SS, modl + 5120, last ? nullptr : (modl + 2 * 6144 + 1024), last ? nullptr : (args.in[4] + (size_t)(2 * l + 2) * 1024)};
            pg8::gemm_phase<pg8::EpiResid, pg8::StaticOrder, false, true>(F.lds, g, S, E);
        PH_END
    }
    lraw = 0;
    PH_BEGIN final_norm_phase(F, args); PH_END
#undef PH_ON
#undef PH_BEGIN
#undef PH_END
}

extern "C" void kernel_launch(void* const* d_in, const int* in_sizes, int n_in, void* d_out, int out_size, void* d_ws, size_t ws_size, hipStream_t stream) {
    static int grid = 0;
    if (grid == 0) {
        if (n_in != 19 || in_sizes[0] != M * D || out_size != M * D || ws_size < WS_END) { fprintf(stderr, "kernel_launch: unexpected problem shape (n_in %d, in0 %d, out %d, ws %zu)\n", n_in, n_in > 0 ? in_sizes[0] : -1, out_size, ws_size); grid = -1; return; }
        int dev = 0, cus = 0;
        if (hipGetDevice(&dev) != hipSuccess || hipDeviceGetAttribute(&cus, hipDeviceAttributeMultiprocessorCount, dev) != hipSuccess) { grid = -1; return; }
        if (hipFuncSetAttribute((const void*)skel_fwd, hipFuncAttributeMaxDynamicSharedMemorySize, LDS_BYTES) != hipSuccess) { fprintf(stderr, "kernel_launch: hipFuncSetAttribute failed\n"); grid = -1; return; }
        (void)hipGetLastError();
        grid = cus;
    }
    if (grid < 0) return;
    if (hipMemsetAsync((char*)d_ws + WS_CTL, 0, CTL_ZERO_BYTES, stream) != hipSuccess) return;
    Args a{};
    for (int i = 0; i < 19; ++i) a.in[i] = (const float*)d_in[i];
    a.out = (float*)d_out; a.ws = (unsigned char*)d_ws;
#if MK_MULTI
    for (int p = 0; p < NPHASES; ++p) { a.ph_lo = p; a.ph_hi = p + 1; a.li = 0; hipLaunchKernelGGL(skel_fwd, dim3(grid), dim3(NWAVES * 64), LDS_BYTES, stream, a); }
#else
    a.ph_lo = 0; a.ph_hi = NPHASES; a.li = 0;
    hipLaunchKernelGGL(skel_fwd, dim3(grid), dim3(NWAVES * 64), LDS_BYTES, stream, a);
#endif
}
```

```cpp
#include <hip/hip_runtime.h>
#include <cstdio>
#include <cstdint>
#include <cmath>
namespace pg8 {
#define PG8_LAS __attribute__((address_space(3)))
typedef unsigned short bf16_t;
typedef short bf16x8 __attribute__((ext_vector_type(8)));
typedef float f32x4 __attribute__((ext_vector_type(4)));
typedef unsigned u32x4 __attribute__((ext_vector_type(4)));
constexpr int BM = 256, BK = 64, HALF = 128, HTB = HALF * BK * 2  , STAGE_BYTES = 8 * HTB, NXCD = 8, WGM = 8;

__host__ __device__ __forceinline__ int lds_byte(int r, int c) { const int st = (r >> 4) * 2 + (c >> 5), rr = r & 15, cc = c & 31, ob = rr * 64 + cc * 2; return st * 1024 + (ob ^ (((ob >> 9) & 1) << 5)); }
__host__ __device__ __forceinline__ void stage_rc(int b, int& R, int& C) { const int st = b / 1024, sb = b % 1024, swz = sb ^ (((sb >> 9) & 1) << 5); R = (st >> 1) * 16 + swz / 64; C = (st & 1) * 32 + (swz % 64) / 2; }
__host__ __device__ __forceinline__ int perm32(int rho) { const int n = rho >> 4, i = rho & 15; return 8 * (i >> 2) + 4 * n + (i & 3); }

struct Unit { int pm, pn, hm; };
struct Gemm { const bf16_t* A; const bf16_t* Bt; int M, N, K; };

struct StaticOrder {
    int nM, nN, nwg, G, c;
    __host__ __device__ void init(int M, int N, int G_, int c_) { nM = M / BM; nN = N / BM; nwg = nM * nN; G = G_; c = c_; }
    __host__ __device__ bool next(int i, Unit& u) const {
        const int nfull = nwg / G, rem = nwg - nfull * G; long L = (long)i * G + c; int hm = 0;
        if (i >= nfull) {
            if (i > nfull || rem == 0) return false;
            if ((G % NXCD) == 0 && (rem % NXCD) == 0 && 2 * rem <= G) { const int j = c / NXCD; if (j >= 2 * (rem / NXCD)) return false; L = (long)nfull * G + NXCD * (j >> 1) + (c % NXCD); hm = 1 + (j & 1); }
            else if (L >= nwg) return false;
        }
        int wgid = (int)L; { const int q = nwg / NXCD, r = nwg % NXCD, xcd = wgid % NXCD, off = wgid / NXCD; wgid = (xcd < r ? xcd * (q + 1) : r * (q + 1) + (xcd - r) * q) + off; }
        const int nig = WGM * nN, gid = wgid / nig, fm = gid * WGM, gsz = (nM - fm) < WGM ? (nM - fm) : WGM;
        u.pm = fm + ((wgid % nig) % gsz); u.pn = (wgid % nig) / gsz; u.hm = hm; return true;
    }
    __device__ __forceinline__ void a_ready(const Unit&) const {}
    __device__ __forceinline__ void done(const Unit&) const {}
};


#define PG8_GAS __attribute__((address_space(1)))
__device__ __forceinline__ unsigned cvt_pk_bf16(float lo, float hi) { unsigned r; asm volatile("v_cvt_pk_bf16_f32 %0, %1, %2" : "=v"(r) : "v"(lo), "v"(hi)); return r; }
__device__ __forceinline__ u32x4 pack8(const f32x4 a, const f32x4 b) { u32x4 w; w.x = cvt_pk_bf16(a[0], a[1]); w.y = cvt_pk_bf16(a[2], a[3]); w.z = cvt_pk_bf16(b[0], b[1]); w.w = cvt_pk_bf16(b[2], b[3]); return w; }
constexpr float K_EPS = 1e-6f, K_LOG2E = 1.4426950408889634f, K_C2 = 0.125f * 1.4426950408889634f;
__device__ __forceinline__ f32x4 ldg4(const float* p) { return *(const PG8_GAS f32x4*)p; }
__device__ __forceinline__ void stg4(float* p, const f32x4 v) { *(PG8_GAS f32x4*)p = v; }
__device__ __forceinline__ void stg8h(bf16_t* p, const u32x4 v) { *(PG8_GAS u32x4*)p = v; }
__device__ __forceinline__ float row_rstd(const float* SS, int row) {
    const PG8_GAS f32x4* p = (const PG8_GAS f32x4*)(SS + (size_t)row * 16);
    const f32x4 a = (p[0] + p[1]) + (p[2] + p[3]);
    const float s = (a[0] + a[1]) + (a[2] + a[3]);
    return 1.0f / sqrtf(s * (1.0f / 1024.0f) + K_EPS);
}
__device__ __forceinline__ void wave_rstd(const float* SS, const Unit& u, int wr, int lane, int fr, float (&rs)[2][4]) {
    const int rb = u.pm * BM + (u.hm == 2 ? HALF : 0) + wr * 64 + lane;
    const float v0 = row_rstd(SS, rb), v1 = u.hm ? v0 : row_rstd(SS, rb + HALF);
#pragma unroll
    for (int m = 0; m < 4; ++m) { rs[0][m] = __shfl(v0, 16 * m + fr); rs[1][m] = __shfl(v1, 16 * m + fr); }
}
__device__ __forceinline__ float silu_f(float v) { return v * __builtin_amdgcn_rcpf(1.0f + __builtin_amdgcn_exp2f(v * -1.4426950408889634f)); }
__device__ __forceinline__ float logsigmoid_f(float v) { return fminf(v, 0.f) - 0.6931471805599453f * __builtin_amdgcn_logf(1.0f + __builtin_amdgcn_exp2f(fabsf(v) * -1.4426950408889634f)); }

struct EpiResid {
    static constexpr bool PERM = true, AFTER_DRAIN = false;
    const float* xin; float* xout; bf16_t* XA; float* SS;
    const float* gate;
    const float* nsc;
    const float* ngain;
    __device__ __forceinline__ void operator()(const f32x4 (&acc)[2][2][4][2], const Unit& u, int wr, int wc, int fr, int fq) const {
        const int b = u.pm >> 5, colt = u.pn * BM + wc * 32 + 8 * fq;
        f32x4 gv[2][2], gm[2][2];
#pragma unroll
        for (int bj = 0; bj < 2; ++bj)
#pragma unroll
            for (int n = 0; n < 2; ++n) {
                const int c = colt + bj * HALF + 4 * n;
                gv[bj][n] = ldg4(gate + (size_t)b * 6144 + c);
                if (nsc) { const f32x4 s = ldg4(nsc + (size_t)b * 6144 + c), g = ldg4(ngain + c); gm[bj][n] = g * (s + 1.0f); } else gm[bj][n] = (f32x4){0.f, 0.f, 0.f, 0.f};
            }
        const int row0 = u.pm * BM + (u.hm == 2 ? HALF : 0) + wr * 64 + fr, nai = u.hm ? 1 : 2;
        f32x4 xc[2][2], xn[2][2];
#pragma unroll
        for (int bj = 0; bj < 2; ++bj) { const size_t off = (size_t)row0 * 1024 + colt + bj * HALF; xc[bj][0] = ldg4(xin + off); xc[bj][1] = ldg4(xin + off + 4); }
#pragma unroll
        for (int g = 0; g < 8; ++g) if ((g >> 2) < nai) {
            const int ai = g >> 2, m = g & 3, row = row0 + ai * HALF + m * 16;
            if (g < 7) { const int rown = row0 + ((g + 1) >> 2) * HALF + ((g + 1) & 3) * 16;
#pragma unroll
                for (int bj = 0; bj < 2; ++bj) { const size_t off = (size_t)rown * 1024 + colt + bj * HALF; xn[bj][0] = ldg4(xin + off); xn[bj][1] = ldg4(xin + off + 4); } }
            float ssq = 0.f;
#pragma unroll
            for (int bj = 0; bj < 2; ++bj) {
                const size_t off = (size_t)row * 1024 + colt + bj * HALF;
                const f32x4 y0 = xc[bj][0] + gv[bj][0] * acc[ai][bj][m][0], y1 = xc[bj][1] + gv[bj][1] * acc[ai][bj][m][1];
                stg4(xout + off, y0); stg4(xout + off + 4, y1);
                ssq += (y0[0] * y0[0] + y0[1] * y0[1]) + (y0[2] * y0[2] + y0[3] * y0[3]) + (y1[0] * y1[0] + y1[1] * y1[1]) + (y1[2] * y1[2] + y1[3] * y1[3]);
                if (nsc) stg8h(XA + off, pack8(y0 * gm[bj][0], y1 * gm[bj][1]));
            }
            ssq += __shfl_xor(ssq, 16); ssq += __shfl_xor(ssq, 32);
            if (fq == 0) *(PG8_GAS float*)(SS + (size_t)row * 16 + 4 * u.pn + wc) = ssq;
#pragma unroll
            for (int bj = 0; bj < 2; ++bj) { xc[bj][0] = xn[bj][0]; xc[bj][1] = xn[bj][1]; }
        }
    }
};

struct EpiFfnGu {
    static constexpr bool PERM = true, AFTER_DRAIN = false;
    const float* SS; const float* shW  ; bf16_t* H  ;
    __device__ __forceinline__ void operator()(const f32x4 (&acc)[2][2][4][2], const Unit& u, int wr, int wc, int fr, int fq) const {
        const int b = u.pm >> 5, cw = wc * 32 + 8 * fq;
        float rs8[2][4]; wave_rstd(SS, u, wr, fq * 16 + fr, fr, rs8);
        f32x4 sg[2], su[2];
#pragma unroll
        for (int n = 0; n < 2; ++n) { sg[n] = ldg4(shW + (size_t)b * 5632 + u.pn * BM + cw + 4 * n); su[n] = ldg4(shW + (size_t)b * 5632 + u.pn * BM + HALF + cw + 4 * n); }
        const int row0 = u.pm * BM + (u.hm == 2 ? HALF : 0) + wr * 64 + fr, nai = u.hm ? 1 : 2;
#pragma unroll
        for (int ai = 0; ai < 2; ++ai) if (ai < nai)
#pragma unroll
            for (int m = 0; m < 4; ++m) {
                const int row = row0 + ai * HALF + m * 16; const float rs = rs8[ai][m];
                f32x4 hv[2];
#pragma unroll
                for (int n = 0; n < 2; ++n) {
                    const f32x4 g = acc[ai][0][m][n] * rs + sg[n], uu = acc[ai][1][m][n] * rs + su[n];
#pragma unroll
                    for (int j = 0; j < 4; ++j) hv[n][j] = silu_f(g[j]) * uu[j];
                }
                stg8h(H + (size_t)row * 2816 + u.pn * HALF + cw, pack8(hv[0], hv[1]));
            }
    }
};

struct EpiSwaIn {
    static constexpr bool PERM = true, AFTER_DRAIN = false;
    const float* SS; const float* shW  ; const float* ropeC; const float* ropeS;
    bf16_t *Q  , *Kb  , *Vb  ;
    __device__ __forceinline__ void operator()(const f32x4 (&acc)[2][2][4][2], const Unit& u, int wr, int wc, int fr, int fq) const {
        const int b = u.pm >> 5, cw = wc * 32 + 8 * fq;
        float rs8[2][4]; wave_rstd(SS, u, wr, fq * 16 + fr, fr, rs8);
        f32x4 sv[2][2];
#pragma unroll
        for (int bj = 0; bj < 2; ++bj)
#pragma unroll
            for (int n = 0; n < 2; ++n) sv[bj][n] = ldg4(shW + (size_t)b * 5632 + u.pn * BM + bj * HALF + cw + 4 * n);
        const int row0 = u.pm * BM + (u.hm == 2 ? HALF : 0) + wr * 64 + fr, nai = u.hm ? 1 : 2;
        if (u.pn < 5) {
            f32x4 cc[2], sc[2], cn[2], sn[2];
#pragma unroll
            for (int n = 0; n < 2; ++n) { const size_t o = (size_t)(row0 & 8191) * 32 + 8 * fq + 4 * n; cc[n] = ldg4(ropeC + o); sc[n] = ldg4(ropeS + o); }
#pragma unroll
            for (int g = 0; g < 8; ++g) if ((g >> 2) < nai) {
                const int ai = g >> 2, m = g & 3, row = row0 + ai * HALF + m * 16; const float rs = rs8[ai][m];
                if (g < 7) { const int rown = row0 + ((g + 1) >> 2) * HALF + ((g + 1) & 3) * 16;
#pragma unroll
                    for (int n = 0; n < 2; ++n) { const size_t o = (size_t)(rown & 8191) * 32 + 8 * fq + 4 * n; cn[n] = ldg4(ropeC + o); sn[n] = ldg4(ropeS + o); } }
                f32x4 o1[2], o2[2];
#pragma unroll
                for (int n = 0; n < 2; ++n) { const f32x4 v0 = acc[ai][0][m][n] * rs + sv[0][n], v1 = acc[ai][1][m][n] * rs + sv[1][n];
                    o1[n] = v0 * cc[n] - v1 * sc[n]; o2[n] = v1 * cc[n] + v0 * sc[n]; }
                if (u.pn < 4) {
                    bf16_t* dst = Q + (size_t)row * 1024 + (4 * u.pn + wc) * 64 + 8 * fq;
                    stg8h(dst, pack8(o1[0] * K_C2, o1[1] * K_C2)); stg8h(dst + 32, pack8(o2[0] * K_C2, o2[1] * K_C2));
                } else {
                    bf16_t* dst = Kb + (size_t)row * 256 + wc * 64 + 8 * fq;
                    stg8h(dst, pack8(o1[0], o1[1])); stg8h(dst + 32, pack8(o2[0], o2[1]));
                }
#pragma unroll
                for (int n = 0; n < 2; ++n) { cc[n] = cn[n]; sc[n] = sn[n]; }
            }
        } else {
#pragma unroll
            for (int ai = 0; ai < 2; ++ai) if (ai < nai)
#pragma unroll
                for (int m = 0; m < 4; ++m) { const int row = row0 + ai * HALF + m * 16; const float rs = rs8[ai][m];
#pragma unroll
                    for (int bj = 0; bj < 2; ++bj) stg8h(Vb + (size_t)row * 256 + bj * HALF + cw, pack8(acc[ai][bj][m][0] * rs + sv[bj][0], acc[ai][bj][m][1] * rs + sv[bj][1])); }
        }
    }
};

struct EpiFoxIn {
    static constexpr bool PERM = true, AFTER_DRAIN = false;
    const float* SS; const float* shW; bf16_t* Q; size_t tstride;
    int* NRM;
    __device__ __forceinline__ void operator()(const f32x4 (&acc)[2][2][4][2], const Unit& u, int wr, int wc, int fr, int fq) const {
        const int b = u.pm >> 5, cw = wc * 32 + 8 * fq, ty = u.pn >> 2;
        float rs8[2][4]; wave_rstd(SS, u, wr, fq * 16 + fr, fr, rs8);
        f32x4 sv[2][2];
#pragma unroll
        for (int bj = 0; bj < 2; ++bj)
#pragma unroll
            for (int n = 0; n < 2; ++n) sv[bj][n] = ldg4(shW + (size_t)b * 5632 + u.pn * BM + bj * HALF + cw + 4 * n);
        bf16_t* base = Q + (size_t)ty * tstride; const float sc = ty == 0 ? K_C2 : 1.0f;
        const int row0 = u.pm * BM + (u.hm == 2 ? HALF : 0) + wr * 64 + fr, col = (u.pn & 3) * BM + cw, nai = u.hm ? 1 : 2;
        float mx[2] = {0.f, 0.f};
#pragma unroll
        for (int ai = 0; ai < 2; ++ai) if (ai < nai)
#pragma unroll
            for (int m = 0; m < 4; ++m) {
                const int row = row0 + ai * HALF + m * 16; const float rs = rs8[ai][m];
#pragma unroll
                for (int bj = 0; bj < 2; ++bj) {
                    const f32x4 a0 = (acc[ai][bj][m][0] * rs + sv[bj][0]) * sc, a1 = (acc[ai][bj][m][1] * rs + sv[bj][1]) * sc;
                    stg8h(base + (size_t)row * 1024 + col + bj * HALF, pack8(a0, a1));
                    if (ty < 2) { float hs = (a0[0] * a0[0] + a0[1] * a0[1]) + (a0[2] * a0[2] + a0[3] * a0[3]) + (a1[0] * a1[0] + a1[1] * a1[1]) + (a1[2] * a1[2] + a1[3] * a1[3]);
                        hs += __shfl_xor(hs, 16); hs += __shfl_xor(hs, 32);
                        mx[bj] = fmaxf(mx[bj], hs); }
                }
            }
        if (ty < 2) {
#pragma unroll
            for (int bj = 0; bj < 2; ++bj) { float v = mx[bj];
                v = fmaxf(v, __shfl_xor(v, 1)); v = fmaxf(v, __shfl_xor(v, 2)); v = fmaxf(v, __shfl_xor(v, 4)); v = fmaxf(v, __shfl_xor(v, 8));
                if (fr == 0 && fq == 0) atomicMax(NRM + ((ty * 2 + b) * 16 + 4 * (u.pn & 3) + 2 * bj + (wc >> 1)) * 2 + (wc & 1), __float_as_int(v)); }
        }
    }
};

struct EpiGlaIn {
    static constexpr bool PERM = true, AFTER_DRAIN = false;
    const float* SS; const float* shW; const float* bgate  ;
    bf16_t* R0;
    __device__ __forceinline__ void operator()(const f32x4 (&acc)[2][2][4][2], const Unit& u, int wr, int wc, int fr, int fq) const {
        const int b = u.pm >> 5, cw = wc * 32 + 8 * fq, pn = u.pn;
        float rs8[2][4]; wave_rstd(SS, u, wr, fq * 16 + fr, fr, rs8);
        f32x4 sv[2][2];
#pragma unroll
        for (int bj = 0; bj < 2; ++bj)
#pragma unroll
            for (int n = 0; n < 2; ++n) sv[bj][n] = ldg4(shW + (size_t)b * 5632 + pn * BM + bj * HALF + cw + 4 * n);
        const int row0 = u.pm * BM + (u.hm == 2 ? HALF : 0) + wr * 64 + fr, nai = u.hm ? 1 : 2;
        if (pn >= 12) {
            const int col = (pn - 12) * BM + cw;
#pragma unroll
            for (int bj = 0; bj < 2; ++bj)
#pragma unroll
                for (int n = 0; n < 2; ++n) sv[bj][n] += ldg4(bgate + col + bj * HALF + 4 * n);
#pragma unroll
            for (int ai = 0; ai < 2; ++ai) if (ai < nai)
#pragma unroll
                for (int m = 0; m < 4; ++m) {
                    const int row = row0 + ai * HALF + m * 16; const float rs = rs8[ai][m];
#pragma unroll
                    for (int bj = 0; bj < 2; ++bj)
#pragma unroll
                        for (int n = 0; n < 2; ++n) { const f32x4 g = acc[ai][bj][m][n] * rs + sv[bj][n]; f32x4 o;
#pragma unroll
                            for (int j = 0; j < 4; ++j) o[j] = logsigmoid_f(g[j]) * (1.0f / 16.0f);
                            stg4((float*)(R0 + (size_t)48 * 1048576) + (size_t)row * 512 + col + bj * HALF + 4 * n, o); }
                }
            return;
        }
        const bool act = (pn >= 8);
        const int offmib = (pn >= 2 ? 16 : 0) + (pn >= 4 ? 16 : 0) + (pn >= 8 ? 32 : 0);
        const int pitch = pn < 4 ? 512 : 1024; const float sc = pn < 2 ? 0.08838834764831845f : 1.0f;
        const int col = ((pn < 4) ? (pn & 1) : (pn & 3)) * BM + cw;
        bf16_t* base = R0 + (size_t)offmib * 524288;
#pragma unroll
        for (int ai = 0; ai < 2; ++ai) if (ai < nai)
#pragma unroll
            for (int m = 0; m < 4; ++m) {
                const int row = row0 + ai * HALF + m * 16; const float rs = rs8[ai][m];
#pragma unroll
                for (int bj = 0; bj < 2; ++bj) {
                    f32x4 a0 = (acc[ai][bj][m][0] * rs + sv[bj][0]) * sc, a1 = (acc[ai][bj][m][1] * rs + sv[bj][1]) * sc;
                    if (act) {
#pragma unroll
                        for (int j = 0; j < 4; ++j) { a0[j] = silu_f(a0[j]); a1[j] = silu_f(a1[j]); }
                    }
                    stg8h(base + (size_t)row * pitch + col + bj * HALF, pack8(a0, a1));
                }
            }
    }
};
template <class Epi, class Sched, bool ALIGN_EPI = false, bool SP2 = false>
__device__ __forceinline__ void gemm_phase(PG8_LAS unsigned char* lds, const Gemm g, const Sched& S, const Epi& E) {
    int tid_ = threadIdx.x; asm volatile("" : "+v"(tid_));
    const int tid = tid_, wid = __builtin_amdgcn_readfirstlane(tid >> 6), lane = tid & 63, wr = wid >> 2, wc = wid & 3, fr = lane & 15, fq = lane >> 4;
    const int K = g.K, nt = K / BK;
    unsigned voffA[2], voffB[2];
#pragma unroll
    for (int i = 0; i < 2; ++i) { int R, C; stage_rc(tid * 16 + i * 8192, R, C); const int Rb = Epi::PERM ? ((R & ~31) + perm32(R & 31)) : R;
        voffA[i] = (unsigned)(R * K + C) * 2u; voffB[i] = (unsigned)(Rb * K + C) * 2u; }
    const size_t kstep = (size_t)(BK * 2);
    const size_t hstep = (size_t)HALF * K * 2;
    const size_t tstep = 2 * hstep;
    const unsigned ldsw = (unsigned)wid * 1024u;
    const int aoff = lds_byte(wr * 64 + fr, fq * 8), boff = lds_byte(wc * 32 + fr, fq * 8);
#define PG8_SA(b, h) (((b) * 2 + (h)) * HTB)
#define PG8_SB(b, h) ((4 + (b) * 2 + (h)) * HTB)
#define PG8_STAGE(bufoff, gbase, voff) do { _Pragma("unroll") for (int _i = 0; _i < 2; ++_i) \
        __builtin_amdgcn_global_load_lds((const unsigned*)((const char*)(gbase) + (voff)[_i]), (PG8_LAS unsigned*)(lds + (bufoff) + ldsw + _i * 8192), 16, 0, 0); } while (0)
#define PG8_LDA(dst, b, h) do { _Pragma("unroll") for (int m = 0; m < 4; ++m) _Pragma("unroll") for (int k = 0; k < 2; ++k) dst[m][k] = *(const PG8_LAS bf16x8*)(lds + PG8_SA(b, h) + aoff + m * 2048 + k * 1024); } while (0)
#define PG8_LDB(dst, b, h) do { _Pragma("unroll") for (int n = 0; n < 2; ++n) _Pragma("unroll") for (int k = 0; k < 2; ++k) dst[n][k] = *(const PG8_LAS bf16x8*)(lds + PG8_SB(b, h) + boff + n * 2048 + k * 1024); } while (0)
#define PG8_MMA(ai, bj, At, Bt) do { __builtin_amdgcn_s_setprio(1); _Pragma("unroll") for (int m = 0; m < 4; ++m) _Pragma("unroll") for (int n = 0; n < 2; ++n) _Pragma("unroll") for (int k = 0; k < 2; ++k) \
        acc[ai][bj][m][n] = __builtin_amdgcn_mfma_f32_16x16x32_bf16(Bt[n][k], At[m][k], acc[ai][bj][m][n], 0, 0, 0); __builtin_amdgcn_s_setprio(0); } while (0)
#define PG8_WAIT_V(n) asm volatile("s_waitcnt vmcnt(" #n ")" ::: "memory")
#define PG8_WAIT_L(n) asm volatile("s_waitcnt lgkmcnt(" #n ")" ::: "memory")
#define PG8_BAR __builtin_amdgcn_s_barrier()
#define PG8_SCHED __builtin_amdgcn_sched_barrier(0)
    Unit cur, nxt; int ui = 0;
    if (!S.next(0, cur)) return;
    f32x4 acc[2][2][4][2];
#pragma unroll
    for (int a = 0; a < 2; ++a)
#pragma unroll
        for (int b = 0; b < 2; ++b)
#pragma unroll
            for (int m = 0; m < 4; ++m)
#pragma unroll
                for (int n = 0; n < 2; ++n) acc[a][b][m][n] = (f32x4){0.f, 0.f, 0.f, 0.f};
    bf16x8 At[4][2], B0[2][2], B1[2][2];
    const char* cA = (const char*)g.A + (size_t)cur.pm * tstep + (cur.hm == 2 ? hstep : (size_t)0); const char* cB = (const char*)g.Bt + (size_t)cur.pn * tstep;
    S.a_ready(cur);
    if constexpr (SP2) {
        PG8_STAGE(PG8_SB(0, 0), cB, voffB); PG8_STAGE(PG8_SB(0, 1), cB + hstep, voffB); PG8_STAGE(PG8_SA(0, 0), cA, voffA); PG8_STAGE(PG8_SA(0, 1), cA + hstep, voffA);
        if (wr == 1) PG8_BAR;
        PG8_WAIT_V(2); PG8_BAR;
        PG8_STAGE(PG8_SB(1, 0), cB + kstep, voffB); PG8_STAGE(PG8_SA(1, 0), cA + kstep, voffA); PG8_STAGE(PG8_SB(1, 1), cB + hstep + kstep, voffB);
        PG8_WAIT_V(6); PG8_BAR;
    } else {
        PG8_STAGE(PG8_SB(0, 0), cB, voffB); PG8_STAGE(PG8_SA(0, 0), cA, voffA); PG8_STAGE(PG8_SB(0, 1), cB + hstep, voffB); PG8_STAGE(PG8_SA(0, 1), cA + hstep, voffA);
        if (wr == 1) PG8_BAR;
        PG8_WAIT_V(4); PG8_BAR;
        PG8_STAGE(PG8_SB(1, 0), cB + kstep, voffB); PG8_STAGE(PG8_SA(1, 0), cA + kstep, voffA); PG8_STAGE(PG8_SB(1, 1), cB + hstep + kstep, voffB);
        PG8_WAIT_V(6); PG8_BAR;
    }
    for (;;) {
        const bool has_next = S.next(ui + 1, nxt);
        const bool full = (cur.hm == 0);
        const char* nA = has_next ? (const char*)g.A + (size_t)nxt.pm * tstep + (nxt.hm == 2 ? hstep : (size_t)0) : cA; const char* nB = has_next ? (const char*)g.Bt + (size_t)nxt.pn * tstep : cB;
        for (int t = 0; t < nt; t += 2) {
            const bool last = (t == nt - 2);
            const char* a1 = cA + (size_t)(t + 1) * kstep;
            const char* a2 = last ? nA : cA + (size_t)(t + 2) * kstep; const char* b2 = last ? nB : cB + (size_t)(t + 2) * kstep;
            const char* a3 = a2 + kstep; const char* b3 = b2 + kstep;
            if (last && has_next) S.a_ready(nxt);
            if constexpr (SP2) {
            PG8_LDB(B0, 0, 0); PG8_LDB(B1, 0, 1); PG8_SCHED; PG8_LDA(At, 0, 0); PG8_STAGE(PG8_SA(1, 1), a1 + hstep, voffA);
            PG8_WAIT_V(8); PG8_WAIT_L(0); PG8_BAR; PG8_MMA(0, 0, At, B0); PG8_MMA(0, 1, At, B1); PG8_BAR; PG8_SCHED;
            PG8_LDA(At, 0, 1); PG8_STAGE(PG8_SB(0, 0), b2, voffB); PG8_STAGE(PG8_SB(0, 1), b2 + hstep, voffB); PG8_STAGE(PG8_SA(0, 0), a2, voffA);
            PG8_WAIT_V(8); PG8_WAIT_L(0); PG8_BAR; if (full) { PG8_MMA(1, 0, At, B0); PG8_MMA(1, 1, At, B1); } PG8_BAR; PG8_SCHED;
            PG8_LDB(B0, 1, 0); PG8_LDB(B1, 1, 1); PG8_SCHED; PG8_LDA(At, 1, 0); PG8_STAGE(PG8_SA(0, 1), a2 + hstep, voffA);
            PG8_WAIT_V(8); PG8_WAIT_L(0); PG8_BAR; PG8_MMA(0, 0, At, B0); PG8_MMA(0, 1, At, B1); PG8_BAR; PG8_SCHED;
            PG8_LDA(At, 1, 1); PG8_STAGE(PG8_SB(1, 0), b3, voffB); PG8_STAGE(PG8_SB(1, 1), b3 + hstep, voffB); PG8_STAGE(PG8_SA(1, 0), a3, voffA);
            PG8_WAIT_V(8); PG8_WAIT_L(0); PG8_BAR; if (full) { PG8_MMA(1, 0, At, B0); PG8_MMA(1, 1, At, B1); } PG8_BAR; PG8_SCHED;
            } else {
            PG8_LDB(B0, 0, 0); PG8_SCHED; PG8_LDA(At, 0, 0); PG8_STAGE(PG8_SA(1, 1), a1 + hstep, voffA);
            PG8_WAIT_L(8); PG8_BAR; PG8_WAIT_L(0); PG8_MMA(0, 0, At, B0); PG8_BAR; PG8_SCHED;
            PG8_LDB(B1, 0, 1); PG8_STAGE(PG8_SB(0, 0), b2, voffB);
            PG8_BAR; PG8_WAIT_L(0); PG8_MMA(0, 1, At, B1); PG8_BAR;
            PG8_LDA(At, 0, 1); PG8_STAGE(PG8_SA(0, 0), a2, voffA);
            PG8_BAR; PG8_WAIT_L(0); PG8_MMA(1, 0, At, B0); PG8_BAR; PG8_SCHED;
            PG8_STAGE(PG8_SB(0, 1), b2 + hstep, voffB);
            PG8_WAIT_V(6); PG8_BAR; PG8_MMA(1, 1, At, B1); PG8_BAR;
            PG8_LDB(B0, 1, 0); PG8_SCHED; PG8_LDA(At, 1, 0); PG8_STAGE(PG8_SA(0, 1), a2 + hstep, voffA);
            PG8_WAIT_L(8); PG8_BAR; PG8_WAIT_L(0); PG8_MMA(0, 0, At, B0); PG8_BAR; PG8_SCHED;
            PG8_LDB(B1, 1, 1); PG8_STAGE(PG8_SB(1, 0), b3, voffB);
            PG8_BAR; PG8_WAIT_L(0); PG8_MMA(0, 1, At, B1); PG8_BAR;
            PG8_LDA(At, 1, 1); PG8_STAGE(PG8_SA(1, 0), a3, voffA);
            PG8_BAR; PG8_WAIT_L(0); PG8_MMA(1, 0, At, B0); PG8_BAR; PG8_SCHED;
            PG8_STAGE(PG8_SB(1, 1), b3 + hstep, voffB);
            PG8_WAIT_V(6); PG8_BAR; PG8_MMA(1, 1, At, B1); PG8_BAR;
            }
        }
        if constexpr (ALIGN_EPI) { if (wr == 0) PG8_BAR; }
        if constexpr (!Epi::AFTER_DRAIN) { E(acc, cur, wr, wc, fr, fq); S.done(cur); }
        if (!has_next) break;
#pragma unroll
        for (int a = 0; a < 2; ++a)
#pragma unroll
            for (int b = 0; b < 2; ++b)
#pragma unroll
                for (int m = 0; m < 4; ++m)
#pragma unroll
                    for (int n = 0; n < 2; ++n) acc[a][b][m][n] = (f32x4){0.f, 0.f, 0.f, 0.f};
        cur = nxt; cA = nA; cB = nB; ++ui;
        if constexpr (ALIGN_EPI) { if (wr == 1) PG8_BAR; }
    }
    PG8_WAIT_V(0);
    if constexpr (!ALIGN_EPI) { if (wr == 0) PG8_BAR; }
    PG8_BAR;
    if constexpr (Epi::AFTER_DRAIN) { E.fused(acc, cur, wr, wc, fr, fq, lds, wid, lane); S.done(cur); }
#undef PG8_SA
#undef PG8_SB
#undef PG8_STAGE
#undef PG8_LDA
#undef PG8_LDB
#undef PG8_MMA
#undef PG8_WAIT_V
#undef PG8_WAIT_L
#undef PG8_BAR
#undef PG8_SCHED
}
}
#include <hip/hip_bf16.h>
#include <cmath>
namespace attn_body {
using bf16=__hip_bfloat16;
using bf16x8=__attribute__((ext_vector_type(8)))short;
using s16x4=__attribute__((ext_vector_type(4)))short;
using f32x16=__attribute__((ext_vector_type(16)))float;
using u32x4=__attribute__((ext_vector_type(4)))unsigned;
constexpr int BATCH=2,NHEAD=16,SEQ=8192,D=64,DM=NHEAD*D;
constexpr int NW=8,QBLK=32,QB=QBLK*NW,KVBLK=64,NQB=SEQ/QB;
constexpr int ATTN_PITCH=DM, ATTN_UNIT_ROWS=QB;
__device__ __forceinline__ int crow(int r,int hi){return (r&3)+8*(r>>2)+4*hi;}
#define SBAR() __builtin_amdgcn_sched_barrier(0)
__device__ __forceinline__ void cmask(f32x16&p0,f32x16&p1,int jb,int qrel,int hi){
  const float NEG=-INFINITY; int kb=64*jb+4*hi;
  #pragma unroll
  for(int r=0;r<16;++r){int kv=kb+(r&3)+8*(r>>2); if(kv>qrel)p0[r]=NEG; if(kv+32>qrel)p1[r]=NEG;}
}

constexpr int NSLOT=3, SLOTB=8192;
constexpr int LDS_K=0, LDS_V=NSLOT*SLOTB, LDS_WS=2*NSLOT*SLOTB, LDS_OST=LDS_WS+NW*64*4, LDS_BYTES=LDS_OST+NW*4096;
constexpr float C2=0.125f*1.4426950408889634f;
__device__ __forceinline__ void glds16(const void*gsrc,unsigned lds_dst){unsigned keep;
  asm volatile("s_mov_b32 %0, m0\n\ts_mov_b32 m0, %2\n\ts_nop 0\n\tglobal_load_lds_dwordx4 %1, off\n\ts_mov_b32 m0, %0":"=&s"(keep):"v"(gsrc),"s"(lds_dst):"memory");}
__device__ __forceinline__ float max3f(float a,float b,float c){float r;asm("v_max3_f32 %0, %1, %2, %3":"=v"(r):"v"(a),"v"(b),"v"(c));return r;}
__device__ __forceinline__ float max2f(float a,float b){float r;asm("v_max_f32_e32 %0, %1, %2":"=v"(r):"v"(a),"v"(b));return r;}
__device__ __forceinline__ float fadd_s(float a,float b){float r;asm("v_add_f32_e32 %0, %1, %2":"=v"(r):"v"(a),"v"(b));return r;}
__device__ __forceinline__ float fsub_s(float a,float b){float r;asm("v_sub_f32_e32 %0, %1, %2":"=v"(r):"v"(a),"v"(b));return r;}
typedef float f32x2_t __attribute__((ext_vector_type(2))); typedef __bf16 bf16x2_t __attribute__((ext_vector_type(2)));
__device__ __forceinline__ unsigned cvtpk_s(float lo,float hi){f32x2_t v={lo,hi};bf16x2_t b=__builtin_convertvector(v,bf16x2_t);return __builtin_bit_cast(unsigned,b);}
#define WAIT_BAR(N) asm volatile("s_waitcnt vmcnt(" #N ") lgkmcnt(0)\n\ts_barrier":::"memory")

__device__ __forceinline__ void qkt(f32x16&p0,f32x16&p1,const char*Kslot,const bf16x8*qr,const f32x16&c0,const f32x16&c1,int r32,int hi){
  const char*kb=Kslot+hi*1024+r32*16;
  #pragma unroll
  for(int d0=0;d0<4;++d0){
    const bf16x8 b0=*reinterpret_cast<const bf16x8*>(kb+d0*2048);
    const bf16x8 b1=*reinterpret_cast<const bf16x8*>(kb+d0*2048+512);
    if(d0==0){p0=__builtin_amdgcn_mfma_f32_32x32x16_bf16(b0,qr[0],c0,0,0,0);p1=__builtin_amdgcn_mfma_f32_32x32x16_bf16(b1,qr[0],c1,0,0,0);}
    else{p0=__builtin_amdgcn_mfma_f32_32x32x16_bf16(b0,qr[d0],p0,0,0,0);p1=__builtin_amdgcn_mfma_f32_32x32x16_bf16(b1,qr[d0],p1,0,0,0);}}
}
typedef __attribute__((address_space(3))) const char* lds_cptr;
typedef short v4i16_t __attribute__((ext_vector_type(4)));
__device__ __forceinline__ void kload8(bf16x8*kf,lds_cptr kp){
  kf[0]=*(const __attribute__((address_space(3))) bf16x8*)(kp);      kf[1]=*(const __attribute__((address_space(3))) bf16x8*)(kp+512);
  kf[2]=*(const __attribute__((address_space(3))) bf16x8*)(kp+2048); kf[3]=*(const __attribute__((address_space(3))) bf16x8*)(kp+2560);
  kf[4]=*(const __attribute__((address_space(3))) bf16x8*)(kp+4096); kf[5]=*(const __attribute__((address_space(3))) bf16x8*)(kp+4608);
  kf[6]=*(const __attribute__((address_space(3))) bf16x8*)(kp+6144); kf[7]=*(const __attribute__((address_space(3))) bf16x8*)(kp+6656);
}
__device__ __forceinline__ void kload2(bf16x8*kf,lds_cptr kp,int j){ kf[2*j]=*(const __attribute__((address_space(3))) bf16x8*)(kp+j*2048); kf[2*j+1]=*(const __attribute__((address_space(3))) bf16x8*)(kp+j*2048+512); }
__device__ __forceinline__ s16x4 vtr(lds_cptr p){ return __builtin_bit_cast(s16x4,__builtin_amdgcn_ds_read_tr16_b64_v4i16((__attribute__((address_space(3))) v4i16_t*)p)); }
__device__ __forceinline__ float rowmax(const f32x16&p0,const f32x16&p1){
  float a=max3f(p0[0],p0[1],p1[0]),b=max3f(p0[2],p0[3],p1[1]);a=max3f(a,p1[2],p1[3]);
  #pragma unroll
  for(int r=4;r<16;r+=4){a=max3f(a,p0[r],p0[r+1]);b=max3f(b,p0[r+2],p0[r+3]);a=max3f(a,p1[r],p1[r+1]);b=max3f(b,p1[r+2],p1[r+3]);}
  const float m=max2f(a,b);
  auto rr=__builtin_amdgcn_permlane32_swap(__float_as_uint(m),__float_as_uint(m),false,false);
  return max2f(__uint_as_float(rr[0]),__uint_as_float(rr[1]));
}
__device__ __forceinline__ void pv(f32x16*o,int vb,bf16x8 pa0,bf16x8 pa1,bf16x8 pa2,bf16x8 pa3){
  #pragma unroll
  for(int d0=0;d0<2;++d0){s16x4 lo[4],hi[4];
    #pragma unroll
    for(int ks=0;ks<4;++ks){
      asm volatile("ds_read_b64_tr_b16 %0,%1 offset:%c2":"=&v"(lo[ks]):"v"(vb),"i"(d0*4096+ks*1024):"memory");
      asm volatile("ds_read_b64_tr_b16 %0,%1 offset:%c2":"=&v"(hi[ks]):"v"(vb),"i"(d0*4096+ks*1024+512):"memory");}
    asm volatile("s_waitcnt lgkmcnt(0)":::"memory");SBAR();
    #define PK(k) (bf16x8){lo[k][0],lo[k][1],lo[k][2],lo[k][3],hi[k][0],hi[k][1],hi[k][2],hi[k][3]}
    o[d0]=__builtin_amdgcn_mfma_f32_32x32x16_bf16(pa0,PK(0),o[d0],0,0,0);
    o[d0]=__builtin_amdgcn_mfma_f32_32x32x16_bf16(pa1,PK(1),o[d0],0,0,0);
    o[d0]=__builtin_amdgcn_mfma_f32_32x32x16_bf16(pa2,PK(2),o[d0],0,0,0);
    o[d0]=__builtin_amdgcn_mfma_f32_32x32x16_bf16(pa3,PK(3),o[d0],0,0,0);
    #undef PK
  }
}

#ifndef ATTN_STORE16
#define ATTN_STORE16(p,v) (*(u32x4*)(p)=(v))
#endif
typedef __attribute__((address_space(3))) const float* lds_fptr; typedef float f32x4_t __attribute__((ext_vector_type(4)));
#define NBINIT(C0,C1,t) do{ const lds_fptr nbp_=nbl+64*(t)+4*hi; _Pragma("unroll") for(int g_=0;g_<4;++g_){ const f32x4_t a_=*(const __attribute__((address_space(3))) f32x4_t*)(nbp_+8*g_), b_=*(const __attribute__((address_space(3))) f32x4_t*)(nbp_+32+8*g_); \
    _Pragma("unroll") for(int j_=0;j_<4;++j_){ C0[4*g_+j_]=a_[j_]-mhat; C1[4*g_+j_]=b_[j_]-mhat; } } }while(0)
template<int THRL> __device__ __forceinline__ void attn_unit(int b,int h,int qb,const bf16*Q,const bf16*__restrict__ K,const bf16*__restrict__ V,bf16*O,char*shm,lds_fptr nbl0,int jstart){
  int tid_=threadIdx.x; asm volatile("":"+v"(tid_));
  const int tid=tid_,lane=tid&63,r32=lane&31,hi=lane>>5; const int wid=__builtin_amdgcn_readfirstlane(tid>>6);
  const long rowbase=(long)b*SEQ; const int q0=qb*QB;
  const bf16*Qw=Q+(rowbase+q0+wid*QBLK)*DM+h*D;
  const bf16*Kh=K+(rowbase+(long)jstart*KVBLK)*DM+h*D,*Vh=V+(rowbase+(long)jstart*KVBLK)*DM+h*D; const lds_fptr nbl=nbl0+64*jstart;
  const unsigned lds0=(unsigned)(uintptr_t)shm;
  float*wsf=(float*)(shm+LDS_WS)+wid*64;
  const bf16*ksrc=Kh+(long)lane*DM+wid*8;
  const bf16*vsrc=Vh+(long)(16*(wid&3)+(lane>>2))*DM+(wid>>2)*32+(lane&3)*8;
  const unsigned kdst=lds0+LDS_K+wid*1024, vdst=lds0+LDS_V+wid*1024;
  #define DMA_K(t,slot) glds16(ksrc+(long)(t)*KVBLK*DM,(unsigned)__builtin_amdgcn_readfirstlane(kdst+(slot)))
  #define DMA_V(t,slot) glds16(vsrc+(long)(t)*KVBLK*DM,(unsigned)__builtin_amdgcn_readfirstlane(vdst+(slot)))
  const int vb0=(int)(lds0+LDS_V)+((lane>>4)&1)*32+(lane&3)*8+(4*hi+((lane&15)>>2))*64;
  const char*Kbase=shm+LDS_K; bf16x8 kf[8];
  const lds_cptr shm3=(lds_cptr)shm; const lds_cptr kp0=shm3+LDS_K+hi*1024+r32*16; const lds_cptr vp0=shm3+LDS_V+((lane>>4)&1)*32+(lane&3)*8+(4*hi+((lane&15)>>2))*64;
  const int NT=(q0+QB)/KVBLK-jstart;
  DMA_K(0,0);DMA_V(0,0);DMA_K(1,SLOTB);
  bf16x8 qr[4];
  #pragma unroll
  for(int d0=0;d0<4;++d0)qr[d0]=*reinterpret_cast<const bf16x8*>(&Qw[(long)r32*DM+d0*16+hi*8]);
  float mhat=0.f,l_reg=0.f;f32x16 o[2];o[0]=f32x16{};o[1]=f32x16{};
  const int qrel=wid*QBLK+r32;
  #define CMASK(P0,P1,t) do{int jb_=(t)-(NT-4); if(jb_>=0)cmask(P0,P1,jb_,qrel,hi);}while(0)
  bool resc=false;
  #define START(P0,P1) do{ const float rm=rowmax(P0,P1); resc=false; \
    { const float dl=rm; mhat=fadd_s(mhat,dl); \
      _Pragma("unroll") for(int r=0;r<16;++r){P0[r]=fsub_s(P0[r],dl);P1[r]=fsub_s(P1[r],dl);} \
      } \
    _Pragma("unroll") for(int r=0;r<16;++r)P0[r]=__builtin_amdgcn_exp2f(P0[r]); }while(0)
  #define RESC() do{ if(resc){ asm volatile("s_waitcnt lgkmcnt(0)":::"memory"); \
      _Pragma("unroll") for(int d_=0;d_<2;++d_) _Pragma("unroll") for(int r=0;r<16;++r)o[d_][r]*=wsf[crow(r,hi)]; } }while(0)
  f32x16 pA0,pA1,pB0,pB1;
  int sl_prev=0,sl_cur=0,sl_next=SLOTB;
  #define ROT() do{sl_prev=sl_cur;sl_cur=sl_next;sl_next=(sl_next==(NSLOT-1)*SLOTB)?0:sl_next+SLOTB;}while(0)
  DMA_K(2,2*SLOTB);
  WAIT_BAR(3);
  { f32x16 c0_,c1_; NBINIT(c0_,c1_,0); qkt(pA0,pA1,Kbase,qr,c0_,c1_,r32,hi); } asm volatile("s_nop 15\n\ts_nop 7":"+v"(pA0),"+v"(pA1));CMASK(pA0,pA1,0);
  START(pA0,pA1);
  _Pragma("unroll") for(int r=0;r<16;++r)pA1[r]=__builtin_amdgcn_exp2f(pA1[r]);
  WAIT_BAR(0);
  DMA_K(3,0);DMA_V(1,SLOTB);
  ROT();
  kload8(kf,kp0+sl_cur);
  WAIT_BAR(2);
  s16x4 vlo[8],vhi[8]; u32x4 pw0,pw1,pw2,pw3;
  #define PKW(P,B) cvtpk_s(P[B],P[B+1])
  #define PAF(k) __builtin_bit_cast(bf16x8,pw##k)
  #define VFR(i) (bf16x8){vlo[i][0],vlo[i][1],vlo[i][2],vlo[i][3],vhi[i][0],vhi[i][1],vhi[i][2],vhi[i][3]}
  #define PIN(x) asm volatile("":"+v"(x))
  #define MX3(a,b,c) __builtin_fmaxf(__builtin_fmaxf((a),(b)),(c))
  #define GAPA(MF,A0,A1,A2,A3,W0,W1,PW) do{ MF; sacc+=A0; sacc+=A1; sacc+=A2; sacc+=A3; PIN(sacc); W0; W1; PIN(PW); SBAR(); }while(0)
  #define EX(v) __builtin_amdgcn_exp2f(v)
  #define GAPB(MF,X,B) do{ MF; X[B]=EX(X[B]); X[B+1]=EX(X[B+1]); X[B+2]=EX(X[B+2]); X[B+3]=EX(X[B+3]); PIN(X); SBAR(); }while(0)
  #define VRD(i) do{ vlo[i]=vtr(vp_+(((i)>>2)*4096+((i)&3)*1024)); vhi[i]=vtr(vp_+(((i)>>2)*4096+((i)&3)*1024+512)); }while(0)
  #define KRD(G,j) do{ if(G){ kload2(kf,kp0+sl_next,j); SBAR(); } }while(0)
  #define STEP(C0,C1,P0,P1,t,GK,GV,GL) do{ SBAR(); NBINIT(C0,C1,t); PIN(C0); PIN(C1); SBAR(); \
    const lds_cptr vp_=vp0+sl_prev; \
    VRD(0); SBAR(); float sacc=(P0[0]+P0[1]); \
    GAPA(C0=__builtin_amdgcn_mfma_f32_32x32x16_bf16(kf[0],qr[0],C0,0,0,0), P0[2],P0[3],P0[4],P0[5],     pw0[0]=PKW(P0,0), pw0[1]=PKW(P0,2), pw0); \
    VRD(4); SBAR(); GAPA(C1=__builtin_amdgcn_mfma_f32_32x32x16_bf16(kf[1],qr[0],C1,0,0,0), P0[6],P0[7],P0[8],P0[9],     pw0[2]=PKW(P0,4), pw0[3]=PKW(P0,6), pw0); \
    VRD(1); SBAR(); GAPA(C0=__builtin_amdgcn_mfma_f32_32x32x16_bf16(kf[2],qr[1],C0,0,0,0),   P0[10],P0[11],P0[12],P0[13], pw1[0]=PKW(P0,8), pw1[1]=PKW(P0,10), pw1); \
    VRD(5); SBAR(); GAPA(C1=__builtin_amdgcn_mfma_f32_32x32x16_bf16(kf[3],qr[1],C1,0,0,0),   P0[14],P0[15],P1[0],P1[1],   pw1[2]=PKW(P0,12),pw1[3]=PKW(P0,14), pw1); \
    VRD(2); SBAR(); GAPA(C0=__builtin_amdgcn_mfma_f32_32x32x16_bf16(kf[4],qr[2],C0,0,0,0),   P1[2],P1[3],P1[4],P1[5],     pw2[0]=PKW(P1,0), pw2[1]=PKW(P1,2), pw2); \
    VRD(6); SBAR(); GAPA(C1=__builtin_amdgcn_mfma_f32_32x32x16_bf16(kf[5],qr[2],C1,0,0,0),   P1[6],P1[7],P1[8],P1[9],     pw2[2]=PKW(P1,4), pw2[3]=PKW(P1,6), pw2); \
    VRD(3); SBAR(); GAPA(C0=__builtin_amdgcn_mfma_f32_32x32x16_bf16(kf[6],qr[3],C0,0,0,0),   P1[10],P1[11],P1[12],P1[13], pw3[0]=PKW(P1,8), pw3[1]=PKW(P1,10), pw3); \
    VRD(7); SBAR(); GAPA(C1=__builtin_amdgcn_mfma_f32_32x32x16_bf16(kf[7],qr[3],C1,0,0,0),   P1[14],P1[15],0.f,0.f,       pw3[2]=PKW(P1,12),pw3[3]=PKW(P1,14), pw3); \
    l_reg+=sacc; \
    if(GK){DMA_K((t)+3,sl_cur);} if(GV){DMA_V((t)+1,sl_next);} \
    CMASK(C0,C1,t); \
    { float a=MX3(C0[0],C0[1],C1[0]),b=MX3(C0[2],C0[3],C1[1]); a=MX3(a,C1[2],C1[3]); \
      _Pragma("unroll") for(int r=4;r<16;r+=4){a=MX3(a,C0[r],C0[r+1]);b=MX3(b,C0[r+2],C0[r+3]);a=MX3(a,C1[r],C1[r+1]);b=MX3(b,C1[r+2],C1[r+3]);} \
      float rm=__builtin_fmaxf(a,b); { auto rr=__builtin_amdgcn_permlane32_swap(__float_as_uint(rm),__float_as_uint(rm),false,false); rm=__builtin_fmaxf(__uint_as_float(rr[0]),__uint_as_float(rr[1])); } \
      resc=false; \
      if(__builtin_expect(__any(rm>(float)THRL),0)){ const float dl=__builtin_fmaxf(rm,0.f); mhat+=dl; \
        _Pragma("unroll") for(int r=0;r<16;++r){C0[r]-=dl;C1[r]-=dl;} \
        const float f=__builtin_amdgcn_exp2f(-dl); l_reg*=f; if(hi==0)wsf[r32]=f; resc=true; } } \
    SBAR(); \
    GAPB(o[0]=__builtin_amdgcn_mfma_f32_32x32x16_bf16(PAF(0),VFR(0),o[0],0,0,0), C0,0); \
    GAPB(o[1]=__builtin_amdgcn_mfma_f32_32x32x16_bf16(PAF(0),VFR(4),o[1],0,0,0), C0,4); \
    KRD(GL,0); GAPB(o[0]=__builtin_amdgcn_mfma_f32_32x32x16_bf16(PAF(1),VFR(1),o[0],0,0,0), C0,8); \
    KRD(GL,1); GAPB(o[1]=__builtin_amdgcn_mfma_f32_32x32x16_bf16(PAF(1),VFR(5),o[1],0,0,0), C0,12); \
    KRD(GL,2); GAPB(o[0]=__builtin_amdgcn_mfma_f32_32x32x16_bf16(PAF(2),VFR(2),o[0],0,0,0), C1,0); \
    KRD(GL,3); GAPB(o[1]=__builtin_amdgcn_mfma_f32_32x32x16_bf16(PAF(2),VFR(6),o[1],0,0,0), C1,4); \
    GAPB(o[0]=__builtin_amdgcn_mfma_f32_32x32x16_bf16(PAF(3),VFR(3),o[0],0,0,0), C1,8); \
    GAPB(o[1]=__builtin_amdgcn_mfma_f32_32x32x16_bf16(PAF(3),VFR(7),o[1],0,0,0), C1,12); \
    }while(0)
  int t=1;
  #undef CMASK
  #define CMASK(P0,P1,t) do{}while(0)
  for(;t+5<NT;t+=2){
    STEP(pB0,pB1,pA0,pA1,t,true,true,true);     WAIT_BAR(2); RESC(); ROT();
    STEP(pA0,pA1,pB0,pB1,t+1,true,true,true);   WAIT_BAR(2); RESC(); ROT();
  }
  #undef CMASK
  #define CMASK(P0,P1,t) do{int jb_=(t)-(NT-4); if(jb_>=0)cmask(P0,P1,jb_,qrel,hi);}while(0)
  #define ENDW(tt) do{ if((tt)+3<NT){WAIT_BAR(2);} else if((tt)+2<NT){WAIT_BAR(1);} else {WAIT_BAR(0);} }while(0)
  for(;t+1<NT;t+=2){
    STEP(pB0,pB1,pA0,pA1,t,(t+3<NT),(t+1<NT),(t+1<NT));       ENDW(t);   RESC(); ROT();
    STEP(pA0,pA1,pB0,pB1,t+1,(t+4<NT),(t+2<NT),(t+2<NT));     ENDW(t+1); RESC(); ROT();
  }
  STEP(pB0,pB1,pA0,pA1,NT-1,false,false,false); RESC();
  { float sacc=pB0[0]+pB0[1]; _Pragma("unroll") for(int r=2;r<16;++r)sacc+=pB0[r]; _Pragma("unroll") for(int r=0;r<16;++r)sacc+=pB1[r]; l_reg+=sacc;
    pw0=(u32x4){PKW(pB0,0),PKW(pB0,2),PKW(pB0,4),PKW(pB0,6)};pw1=(u32x4){PKW(pB0,8),PKW(pB0,10),PKW(pB0,12),PKW(pB0,14)};pw2=(u32x4){PKW(pB1,0),PKW(pB1,2),PKW(pB1,4),PKW(pB1,6)};pw3=(u32x4){PKW(pB1,8),PKW(pB1,10),PKW(pB1,12),PKW(pB1,14)};
    SBAR(); pv(o,vb0+sl_cur,PAF(0),PAF(1),PAF(2),PAF(3)); }
  #undef PKW
  #undef PAF
  #undef VFR
  #undef PIN
  #undef MX3
  #undef GAPA
  #undef GAPB
  #undef EX
  #undef VRD
  #undef KRD
  #undef STEP
  #undef ENDW
  {auto rr=__builtin_amdgcn_permlane32_swap(__float_as_uint(l_reg),__float_as_uint(l_reg),false,false);l_reg=__uint_as_float(rr[0])+__uint_as_float(rr[1]);}
  if(hi==0)wsf[32+r32]=l_reg;asm volatile("s_waitcnt lgkmcnt(0)":::"memory");
  float rli[16];
  #pragma unroll
  for(int r=0;r<16;++r)rli[r]=__builtin_amdgcn_rcpf(wsf[32+crow(r,hi)]);
  bf16*Ow=O+(rowbase+q0+wid*QBLK)*DM+h*D;
  { bf16*stg=(bf16*)(shm+LDS_OST)+wid*2048;
    #pragma unroll
    for(int r=0;r<16;++r){const int orow=crow(r,hi);
      #pragma unroll
      for(int d0=0;d0<2;++d0)stg[orow*64+d0*32+r32]=__float2bfloat16(o[d0][r]*rli[r]);}
    asm volatile("s_waitcnt lgkmcnt(0)":::"memory");
    #pragma unroll
    for(int i=0;i<4;++i){const int row=i*8+(lane>>3),ch=lane&7; const u32x4 v=*(const u32x4*)(stg+row*64+ch*8); ATTN_STORE16(Ow+(long)row*DM+ch*8,v);} }
  asm volatile("s_waitcnt lgkmcnt(0)\n\ts_barrier":::"memory");
  #undef DMA_K
  #undef DMA_V
  #undef CMASK
  #undef START
  #undef RESC
  #undef ROT
}
constexpr int ATTN_LDS_BYTES=LDS_BYTES;
struct AttnTensors { const bf16* Q; const bf16* K; const bf16* V; bf16* O; };
struct AttnUnit { int bh; int qb; };
struct StaticOrder {
  int vcu;
  __device__ __forceinline__ explicit StaticOrder(int grid,int block):vcu((block%8)*(grid/8)+block/8){}
  __device__ __forceinline__ bool next(int i,AttnUnit&u)const{ if(i>=4)return false; const int s=vcu&7; u.bh=vcu>>3; u.qb=(i==0)?s:(i==1)?15-s:(i==2)?16+s:31-s; return true; }
  __device__ __forceinline__ void a_ready(const AttnUnit&)const{}
  __device__ __forceinline__ void done(const AttnUnit&)const{}
};
template<int THRL=8> __device__ __forceinline__ void fox_phase(char*lds,const AttnTensors&T,const float*LFT,const int*NRM,unsigned*QH,int vcu){
  typedef __attribute__((address_space(3))) float* lds_fw;
  lds_fw nbw=(lds_fw)((__attribute__((address_space(3))) char*)lds+LDS_BYTES);
  int tid=threadIdx.x; asm volatile("":"+v"(tid));
  const int lane=tid&63, wv=tid>>6;
  int bh=(vcu>>3)&31, cur_bh=-1; float U2=0.f;
  __attribute__((address_space(3))) volatile int* shq=(__attribute__((address_space(3))) volatile int*)(nbw+8192);
  for(;;){
    if(wv==0){ const unsigned cnt=lane<32?__hip_atomic_load(QH+lane*64,__ATOMIC_RELAXED,__HIP_MEMORY_SCOPE_AGENT):32u;
      const unsigned m32=(unsigned)__ballot(cnt<32u); int sel=-1; unsigned idx=64u;
      if(m32){ const unsigned rot=bh?((m32>>bh)|(m32<<(32-bh))):m32; sel=(bh+__builtin_ctz(rot))&31;
        if(lane==0)idx=__hip_atomic_fetch_add(QH+sel*64,1u,__ATOMIC_RELAXED,__HIP_MEMORY_SCOPE_AGENT); }
      if(lane==0){ shq[15]=(int)idx; shq[14]=sel; } }
    asm volatile("s_waitcnt vmcnt(0) lgkmcnt(0)\n\ts_barrier":::"memory");
    const int idx=shq[15], sel=shq[14];
    asm volatile("s_waitcnt lgkmcnt(0)\n\ts_barrier":::"memory");
    if(sel<0)break;
    if(idx>=32)continue;
    bh=sel;
    const int qb=31-idx;
    if(bh!=cur_bh){ cur_bh=bh;
      const f32x4_t* src=(const f32x4_t*)(LFT+(size_t)bh*SEQ+16*tid); float v[16];
      #pragma unroll
      for(int i=0;i<4;++i){ const f32x4_t x=src[i]; v[4*i]=x[0];v[4*i+1]=x[1];v[4*i+2]=x[2];v[4*i+3]=x[3]; }
      #pragma unroll
      for(int i=1;i<16;++i)v[i]+=v[i-1];
      float inc=v[15];
      #pragma unroll
      for(int o_=1;o_<64;o_<<=1){ const float y=__shfl_up(inc,o_); if(lane>=o_)inc+=y; }
      if(lane==63)nbw[8192+wv]=inc;
      asm volatile("s_waitcnt lgkmcnt(0)\n\ts_barrier":::"memory");
      float pre=inc-v[15];
      #pragma unroll
      for(int w_=0;w_<7;++w_) if(w_<wv)pre+=nbw[8192+w_];
      #pragma unroll
      for(int i=0;i<4;++i){ f32x4_t y; y[0]=-1.4426950408889634f*(pre+v[4*i]); y[1]=-1.4426950408889634f*(pre+v[4*i+1]); y[2]=-1.4426950408889634f*(pre+v[4*i+2]); y[3]=-1.4426950408889634f*(pre+v[4*i+3]);
        *(__attribute__((address_space(3))) f32x4_t*)(nbw+16*tid+4*i)=y; }
      const int b_=bh>>4,h_=bh&15; const int* nq=NRM+((0*2+b_)*16+h_)*2; const int* nk=NRM+((1*2+b_)*16+h_)*2;
      const float qn2=__int_as_float(nq[0])+__int_as_float(nq[1]), kn2=__int_as_float(nk[0])+__int_as_float(nk[1]);
      U2=2.0f*1.03f*sqrtf(qn2*kn2);
      asm volatile("s_waitcnt vmcnt(0) lgkmcnt(0)\n\ts_barrier":::"memory"); }
    int jlo=0,jhi=4*qb; const float ref=nbw[256*qb]-U2-40.0f;
    while(jlo<jhi){ const int mid=(jlo+jhi)>>1; if(nbw[64*mid+63]>=ref)jhi=mid; else jlo=mid+1; }
    const int jstart=__builtin_amdgcn_readfirstlane(jlo&~1);
    attn_unit<THRL>(bh>>4,bh&15,qb,T.Q,T.K,T.V,T.O,lds,(lds_fptr)nbw,jstart);
  }
}
__device__ __forceinline__ void swa_unit(int b,int kvh,int j,const bf16*Q,const bf16*__restrict__ K,const bf16*__restrict__ V,bf16*O,const float*sinks,char*shm){
  int tid_=threadIdx.x; asm volatile("":"+v"(tid_));
  const int tid=tid_,lane=tid&63,r32=lane&31,hi=lane>>5; const int wid=__builtin_amdgcn_readfirstlane(tid>>6);
  const int grp=wid>>1,half=wid&1,qh=kvh*4+grp; const long rowbase=(long)b*SEQ; const int t0=64*j+32*half;
  typedef __attribute__((address_space(3))) char* lds_wptr;
  const lds_wptr shw=(lds_wptr)shm; const lds_cptr shm3=(lds_cptr)shm;
  const unsigned lds0=(unsigned)(uintptr_t)shm;
  float*wsf=(float*)(shm+LDS_WS)+wid*64;
  { const int key=tid>>3,c8=tid&7;
    #pragma unroll
    for(int i=0;i<3;++i){ const int jt=j-2+i; if(jt>=0){
        const long grow=(rowbase+64*jt+key)*256+kvh*64+c8*8;
        const u32x4 kv=*(const u32x4*)(K+grow), vv=*(const u32x4*)(V+grow);
        *(__attribute__((address_space(3))) u32x4*)(shw+LDS_K+i*SLOTB+c8*1024+key*16)=kv;
        *(__attribute__((address_space(3))) u32x4*)(shw+LDS_V+i*SLOTB+(c8>>2)*4096+key*64+(c8&3)*16)=vv; } } }
  const bf16*Qw=Q+(rowbase+t0)*1024+qh*64;
  bf16x8 qr[4];
  #pragma unroll
  for(int d0=0;d0<4;++d0)qr[d0]=*reinterpret_cast<const bf16x8*>(&Qw[(long)r32*1024+d0*16+hi*8]);
  asm volatile("s_waitcnt vmcnt(0) lgkmcnt(0)\n\ts_barrier":::"memory");
  f32x16 p[3][2];
  const lds_cptr kp0=shm3+LDS_K+hi*1024+r32*16;
  #pragma unroll
  for(int i=0;i<3;++i){ const int jt=j-2+i;
    if(jt>=0){ bf16x8 kf[8]; kload8(kf,kp0+i*SLOTB);
      f32x16 c0=f32x16{},c1=f32x16{};
      #pragma unroll
      for(int d0=0;d0<4;++d0){ c0=__builtin_amdgcn_mfma_f32_32x32x16_bf16(kf[2*d0],qr[d0],c0,0,0,0); c1=__builtin_amdgcn_mfma_f32_32x32x16_bf16(kf[2*d0+1],qr[d0],c1,0,0,0); }
      const int dbase=64*(2-i)+32*half+r32-4*hi;
      #pragma unroll
      for(int r=0;r<16;++r){ const int d0_=dbase-((r&3)+8*(r>>2)), d1_=d0_-32;
        p[i][0][r]=(d0_>=0&&d0_<128)?c0[r]:-INFINITY; p[i][1][r]=(d1_>=0&&d1_<128)?c1[r]:-INFINITY; }
    } else {
      #pragma unroll
      for(int r=0;r<16;++r){ p[i][0][r]=-INFINITY; p[i][1][r]=-INFINITY; } } }
  const float sk=sinks[qh]*1.4426950408889634f;
  float m=sk;
  #pragma unroll
  for(int i=0;i<3;++i)
    #pragma unroll
    for(int c=0;c<2;++c)
      #pragma unroll
      for(int r=0;r<16;++r)m=fmaxf(m,p[i][c][r]);
  { auto rr=__builtin_amdgcn_permlane32_swap(__float_as_uint(m),__float_as_uint(m),false,false); m=fmaxf(__uint_as_float(rr[0]),__uint_as_float(rr[1])); }
  float l=0.f;
  #pragma unroll
  for(int i=0;i<3;++i)
    #pragma unroll
    for(int c=0;c<2;++c)
      #pragma unroll
      for(int r=0;r<16;++r){ const float e=__builtin_amdgcn_exp2f(p[i][c][r]-m); p[i][c][r]=e; l+=e; }
  { auto rr=__builtin_amdgcn_permlane32_swap(__float_as_uint(l),__float_as_uint(l),false,false); l=__uint_as_float(rr[0])+__uint_as_float(rr[1]); }
  l+=__builtin_amdgcn_exp2f(sk-m);
  f32x16 o[2]; o[0]=f32x16{}; o[1]=f32x16{};
  const int vb0=(int)(lds0+LDS_V)+((lane>>4)&1)*32+(lane&3)*8+(4*hi+((lane&15)>>2))*64;
  #pragma unroll
  for(int i=0;i<3;++i){ const int jt=j-2+i; if(jt>=0){
      u32x4 w0,w1,w2,w3;
      w0=(u32x4){cvtpk_s(p[i][0][0],p[i][0][1]),cvtpk_s(p[i][0][2],p[i][0][3]),cvtpk_s(p[i][0][4],p[i][0][5]),cvtpk_s(p[i][0][6],p[i][0][7])};
      w1=(u32x4){cvtpk_s(p[i][0][8],p[i][0][9]),cvtpk_s(p[i][0][10],p[i][0][11]),cvtpk_s(p[i][0][12],p[i][0][13]),cvtpk_s(p[i][0][14],p[i][0][15])};
      w2=(u32x4){cvtpk_s(p[i][1][0],p[i][1][1]),cvtpk_s(p[i][1][2],p[i][1][3]),cvtpk_s(p[i][1][4],p[i][1][5]),cvtpk_s(p[i][1][6],p[i][1][7])};
      w3=(u32x4){cvtpk_s(p[i][1][8],p[i][1][9]),cvtpk_s(p[i][1][10],p[i][1][11]),cvtpk_s(p[i][1][12],p[i][1][13]),cvtpk_s(p[i][1][14],p[i][1][15])};
      SBAR(); pv(o,vb0+i*SLOTB,__builtin_bit_cast(bf16x8,w0),__builtin_bit_cast(bf16x8,w1),__builtin_bit_cast(bf16x8,w2),__builtin_bit_cast(bf16x8,w3)); } }
  if(hi==0)wsf[32+r32]=l; asm volatile("s_waitcnt lgkmcnt(0)":::"memory");
  float rli[16];
  #pragma unroll
  for(int r=0;r<16;++r)rli[r]=__builtin_amdgcn_rcpf(wsf[32+crow(r,hi)]);
  bf16*Ow=O+(rowbase+t0)*1024+qh*64;
  { bf16*stg=(bf16*)(shm+LDS_OST)+wid*2048;
    #pragma unroll
    for(int r=0;r<16;++r){const int orow=crow(r,hi);
      #pragma unroll
      for(int d0=0;d0<2;++d0)stg[orow*64+d0*32+r32]=__float2bfloat16(o[d0][r]*rli[r]);}
    asm volatile("s_waitcnt lgkmcnt(0)":::"memory");
    #pragma unroll
    for(int i=0;i<4;++i){const int row=i*8+(lane>>3),ch=lane&7; const u32x4 v=*(const u32x4*)(stg+row*64+ch*8); ATTN_STORE16(Ow+(long)row*1024+ch*8,v);} }
  asm volatile("s_waitcnt lgkmcnt(0)\n\ts_barrier":::"memory");
}
__device__ __forceinline__ void swa_phase(char*lds,const bf16*Q,const bf16*K,const bf16*V,bf16*O,const float*sinks,int grid,int block){
  const int per=(1024+grid-1)/grid;
  for(int i=0;i<per;++i){ const int u=block*per+i; if(u>=1024)break; swa_unit(u>>9,(u>>7)&3,u&127,Q,K,V,O,sinks,lds); }
}
#undef SBAR
#undef WAIT_BAR
}

#define GAS __attribute__((address_space(1)))
#define LAS __attribute__((address_space(3)))
typedef unsigned short bf16;
typedef unsigned v4u __attribute__((ext_vector_type(4)));
typedef float f32x4 __attribute__((ext_vector_type(4)));
typedef short bf16x8 __attribute__((ext_vector_type(8)));
typedef GAS unsigned gu32;
typedef GAS unsigned long long gu64;
#define RLX_AGENT __ATOMIC_RELAXED, __HIP_MEMORY_SCOPE_AGENT
#define LDS_WAIT() asm volatile("s_waitcnt lgkmcnt(0)" ::: "memory")
#define VM_WAIT() asm volatile("s_waitcnt vmcnt(0)" ::: "memory")
__device__ __forceinline__ unsigned long long rt() { return __builtin_amdgcn_s_memrealtime(); }
__device__ __forceinline__ unsigned f2bf(float f) { unsigned u = __builtin_bit_cast(unsigned, f); return (u + 0x7fffu + ((u >> 16) & 1u)) >> 16; }
__device__ __forceinline__ unsigned pk2(float lo, float hi) { return f2bf(lo) | (f2bf(hi) << 16); }

#define XB_TMO      128
#define XB_XCNT(j)  (256  + 64 * (j))
#define XB_XSUB(j)  (1280 + 64 * (j))
#define XB_XGEN(j)  (2304 + 64 * (j))
#define XB_TOP      3328
#define XB_TOPGEN   3392
#define XCD_BAR_WORDS 3456
#define XB_SPIN_CAP (1u << 18)

__device__ __forceinline__ unsigned xb_ld(unsigned* p)              { return __hip_atomic_load(p, __ATOMIC_RELAXED, __HIP_MEMORY_SCOPE_AGENT); }
__device__ __forceinline__ unsigned xb_add(unsigned* p, unsigned v) { return __hip_atomic_fetch_add(p, v, __ATOMIC_RELAXED, __HIP_MEMORY_SCOPE_AGENT); }
__device__ __forceinline__ unsigned xb_xcc_id() { return (unsigned)__builtin_amdgcn_s_getreg((3 << 11) | 20) & 0xFu; }
#define XB_SPIN(cond, bar) do { unsigned _sp = 0; while (cond) { __builtin_amdgcn_s_sleep(1); \
    if ((++_sp & 255u) == 0u) { if (xb_ld(&(bar)[XB_TMO])) break; if (_sp > XB_SPIN_CAP) { atomicAdd(&(bar)[XB_TMO], 1u); break; } } } } while (0)

struct XcdBarrier {
    unsigned* bar; unsigned x;
    volatile LAS unsigned* st;
};

__device__ __forceinline__ XcdBarrier xcd_barrier_post(unsigned* bar, volatile LAS unsigned* st) {
    XcdBarrier b; b.bar = bar; b.x = xb_xcc_id(); b.st = st;
    if (threadIdx.x == 0) (void)xb_add(&bar[XB_XCNT(b.x)], 1u);
    return b;
}
__device__ __forceinline__ void xcd_barrier_complete(unsigned* bar, unsigned x, unsigned& nloc, unsigned& nx) {
    const unsigned G = gridDim.x * gridDim.y * gridDim.z;
    unsigned sum, cnt, mine, sp = 0u;
    for (;;) {
        sum = 0u; cnt = 0u; mine = 0u;
#pragma unroll
        for (unsigned j = 0; j < 16; ++j) { const unsigned c = xb_ld(&bar[XB_XCNT(j)]); sum += c; cnt += (c > 0u) ? 1u : 0u; mine = (j == x) ? c : mine; }
        if (sum == G) break;
        __builtin_amdgcn_s_sleep(1);
        if ((++sp & 255u) == 0u) { if (xb_ld(&bar[XB_TMO])) break; if (sp > XB_SPIN_CAP) { atomicAdd(&bar[XB_TMO], 1u); break; } }
    }
    nloc = mine > 0u ? mine : 1u; nx = cnt > 0u ? cnt : 1u;
}

__device__ __forceinline__ void xcd_barrier(const XcdBarrier& b) {
    asm volatile("s_waitcnt vmcnt(0)" ::: "memory");
    __syncthreads();
    if (threadIdx.x == 0) {
        unsigned* bar = b.bar;
        __builtin_amdgcn_s_waitcnt(0);
        unsigned nloc = b.st[0], nx = b.st[1];
        if (nloc == 0u) { xcd_barrier_complete(bar, b.x, nloc, nx); b.st[0] = nloc; b.st[1] = nx; }
        const unsigned old = xb_add(&bar[XB_XSUB(b.x)], 1u);
        const unsigned gen = old / nloc;
        if (old + 1u == (gen + 1u) * nloc) {
            __builtin_amdgcn_fence(__ATOMIC_RELEASE, "agent");
            asm volatile("s_waitcnt vmcnt(0)" ::: "memory");
            const unsigned og = xb_add(&bar[XB_TOP], 1u);
            const unsigned tg = og / nx;
            if (og + 1u == (tg + 1u) * nx) xb_add(&bar[XB_TOPGEN], 1u);
            else XB_SPIN(xb_ld(&bar[XB_TOPGEN]) == tg, bar);
            __builtin_amdgcn_fence(__ATOMIC_ACQUIRE, "agent");
            xb_add(&bar[XB_XGEN(b.x)], 1u);
            asm volatile("s_waitcnt vmcnt(0)" ::: "memory");
        } else {
            XB_SPIN(xb_ld(&bar[XB_XGEN(b.x)]) == gen, bar);
            __builtin_amdgcn_fence(__ATOMIC_ACQUIRE, "agent");
            asm volatile("s_waitcnt vmcnt(0)" ::: "memory");
        }
    }
    __syncthreads();
}

#ifndef MK_MULTI
#define MK_MULTI 0
#endif
#ifndef PROBE_MASK
#define PROBE_MASK 0
#endif
constexpr int NWAVES = 8;
constexpr int M = 16384, D = 1024, SEQ = 8192, DFF = 2816, NGU = 5632, DEPTH = 4;
constexpr float EPS = 1e-6f, LOG2E = 1.4426950408889634f;
constexpr size_t MiB = 1u << 20;
constexpr size_t WS_CTL = 0, CTL_ZERO_BYTES = 1 * MiB;
constexpr size_t WS_MOD = 512 * 1024;
constexpr size_t WS_SHW = 1 * MiB;
constexpr size_t WS_ROPC = 2 * MiB, WS_ROPS = 3 * MiB;
constexpr size_t WS_SS = 4 * MiB;
constexpr size_t WS_LCL = 5 * MiB;
constexpr size_t WS_BTOT = 6 * MiB;
constexpr size_t WS_EB = 6 * MiB + 512 * 1024;
constexpr size_t WS_W = 8 * MiB;
constexpr size_t W_SWA_IN0 = WS_W, W_SWA_IN1 = WS_W + 3 * MiB, W_SWA_O0 = WS_W + 6 * MiB, W_SWA_O1 = WS_W + 8 * MiB;
constexpr size_t W_GLA_IN = WS_W + 10 * MiB, W_GLA_O = WS_W + 17 * MiB, W_FOX_IN = WS_W + 19 * MiB, W_FOX_O = WS_W + 26 * MiB;
constexpr size_t W_GU0 = WS_W + 28 * MiB, W_GU_STRIDE = 11 * MiB, W_DN0 = WS_W + 72 * MiB, W_DN_STRIDE = 5 * MiB + 512 * 1024;
constexpr size_t WS_XA = 104 * MiB;
constexpr size_t WS_R = 136 * MiB;
constexpr size_t R_H = 0;
constexpr size_t R_SQ = 0, R_SK = 32 * MiB, R_SV = 40 * MiB, R_SO = 48 * MiB;
constexpr size_t R_FQ = 0, R_FK = 32 * MiB, R_FV = 64 * MiB, R_FO = 96 * MiB;
constexpr size_t R_GQ = 0, R_GK = 16 * MiB, R_GV = 32 * MiB, R_GSR = 64 * MiB, R_GLA = 96 * MiB, R_GO = 128 * MiB, R_GA = 160 * MiB, R_GKV = 168 * MiB;
constexpr size_t WS_END = WS_R + 232 * MiB;
static_assert(W_DN0 + 4 * W_DN_STRIDE <= WS_XA && W_GU0 + 4 * W_GU_STRIDE <= W_DN0, "weight map");
constexpr int CW_BAR = 4096;
constexpr int CW_NRM = 8192;
constexpr int CW_QH = 16384;
constexpr int RING_BYTES = 131072, LDS_BYTES = 147456, LDSCTL_OFF = LDS_BYTES - 512, MISC_OFF = LDSCTL_OFF + 320;
constexpr int NPHASES = 25;

struct Args { const float* in[19]; float* out; unsigned char* ws; int ph_lo, ph_hi, li, pad; };

struct Frame {
    LAS unsigned char* lds; volatile LAS unsigned* MISC; gu32* ctl;
    int tid, lane, wave, vcu, G;
};
__device__ __forceinline__ float bf2f(bf16 h) { return __uint_as_float((unsigned)h << 16); }
__device__ __forceinline__ bf16 f2bf16(float f) { return (bf16)f2bf(f); }
__device__ __forceinline__ float rbf(float f) { return bf2f(f2bf16(f)); }
__device__ __forceinline__ float wave_sum(float v) {
#pragma unroll
    for (int o = 1; o < 64; o <<= 1) v += __shfl_xor(v, o);
    return v;
}
__device__ __forceinline__ float wave_max(float v) {
#pragma unroll
    for (int o = 1; o < 64; o <<= 1) v = fmaxf(v, __shfl_xor(v, o));
    return v;
}
__device__ __forceinline__ float silu_d(float v) { return v / (1.0f + __expf(-v)); }
__device__ __forceinline__ float logsig_d(float v) { return fminf(v, 0.f) - log1pf(__expf(-fabsf(v))); }

__device__ __forceinline__ void p0_transpose_item(const float* W, int K, int pitch, bf16* WT, int n0, int lcol0, int k0, LAS float* scr, int lane) {
#pragma unroll 8
    for (int i = 0; i < 32; ++i) { const int kk = 2 * i + (lane >> 5); scr[kk * 33 + (lane & 31)] = W[(size_t)(k0 + kk) * pitch + lcol0 + (lane & 31)]; }
    LDS_WAIT(); asm volatile("" ::: "memory");
    const int c = lane & 7;
#pragma unroll
    for (int j = 0; j < 4; ++j) { const int n = (lane >> 3) + 8 * j; const LAS float* s = scr + (8 * c) * 33 + n;
        v4u o; o.x = pk2(s[0 * 33], s[1 * 33]); o.y = pk2(s[2 * 33], s[3 * 33]); o.z = pk2(s[4 * 33], s[5 * 33]); o.w = pk2(s[6 * 33], s[7 * 33]);
        *(GAS v4u*)(WT + (size_t)(n0 + n) * K + k0 + 8 * c) = o; }
    LDS_WAIT(); asm volatile("" ::: "memory");
}
__device__ __forceinline__ int map_id(int n0) { return n0; }
__device__ __forceinline__ int map_swa(int n0) { const int t = n0 >> 8, p = n0 & 255; return t < 5 ? (t << 8) + (((p >> 5) & 3) << 6) + (((p >> 7) & 1) << 5) : n0; }
__device__ __forceinline__ int map_ffn(int n0) { const int t = n0 >> 8, p = n0 & 255; return p < 128 ? 128 * t + p : 2816 + 128 * t + (p - 128); }

template <int MAP> __device__ __forceinline__ void conv_mat(Frame& F, const float* W, int K, int pitch, bf16* WT, int Nphys, int r) {
    LAS float* scr = (LAS float*)(F.lds + F.wave * 16384);
    const int nblk = Nphys / 32, kb = r / nblk, nb = r % nblk, n0 = nb * 32;
    const int l0 = MAP == 0 ? map_id(n0) : (MAP == 1 ? map_swa(n0) : map_ffn(n0));
    p0_transpose_item(W, K, pitch, WT, n0, l0, kb * 64, scr, F.lane);
}

__device__ __forceinline__ void p0_prologue(Frame& F, const Args& A) {
    unsigned char* ws = A.ws;
    const int gw = F.vcu * NWAVES + F.wave, NGW = F.G * NWAVES;
    constexpr int I_SWA_IN = 16 * (1536 / 32), I_SQ = 16 * (1024 / 32), I_GLA_IN = 16 * (3072 / 32), I_FOX_IN = 16 * (3072 / 32), I_GU = 16 * (5632 / 32), I_DN = 44 * (1024 / 32);
    constexpr int NITEMS = 2 * I_SWA_IN + 4 * I_SQ + I_GLA_IN + I_FOX_IN + 4 * I_GU + 4 * I_DN;
    for (int rep_ = 0; rep_ < (((PROBE_MASK) & 64) ? 2 : 1); ++rep_)
    for (int it = gw; it < NITEMS; it += NGW) {
        int r = it;
        if (r < 4 * I_GU) { const int l = r / I_GU; conv_mat<2>(F, A.in[5] + (size_t)l * 1024 * 5632, 1024, 5632, (bf16*)(ws + W_GU0 + l * W_GU_STRIDE), 5632, r % I_GU); continue; } r -= 4 * I_GU;
        if (r < 4 * I_DN) { const int l = r / I_DN; conv_mat<0>(F, A.in[6] + (size_t)l * 2816 * 1024, 2816, 1024, (bf16*)(ws + W_DN0 + l * W_DN_STRIDE), 1024, r % I_DN); continue; } r -= 4 * I_DN;
        if (r < 2 * I_SWA_IN) { const int j = r / I_SWA_IN; conv_mat<1>(F, A.in[7] + (size_t)j * 1024 * 1536, 1024, 1536, (bf16*)(ws + (j ? W_SWA_IN1 : W_SWA_IN0)), 1536, r % I_SWA_IN); continue; } r -= 2 * I_SWA_IN;
        if (r < 2 * I_SQ) { const int j = r / I_SQ; conv_mat<0>(F, A.in[9] + (size_t)j * 1024 * 1024, 1024, 1024, (bf16*)(ws + (j ? W_SWA_O1 : W_SWA_O0)), 1024, r % I_SQ); continue; } r -= 2 * I_SQ;
        if (r < I_GLA_IN) { conv_mat<0>(F, A.in[10], 1024, 3088, (bf16*)(ws + W_GLA_IN), 3072, r); continue; } r -= I_GLA_IN;
        if (r < I_SQ) { conv_mat<0>(F, A.in[14], 1024, 1024, (bf16*)(ws + W_GLA_O), 1024, r); continue; } r -= I_SQ;
        if (r < I_FOX_IN) { conv_mat<0>(F, A.in[15], 1024, 3088, (bf16*)(ws + W_FOX_IN), 3072, r); continue; } r -= I_FOX_IN;
        conv_mat<0>(F, A.in[17], 1024, 1024, (bf16*)(ws + W_FOX_O), 1024, r);
    }
    const int gt = (F.vcu * NWAVES + F.wave) * 64 + F.lane, NGT = NGW * 64;
    {   const float* win = A.in[10]; const float* wgu = A.in[11]; bf16* WT = (bf16*)(ws + W_GLA_IN);
        for (int i = gt; i < 512 * 1024; i += NGT) { const int j = i >> 10, k = i & 1023; float s = 0.f;
#pragma unroll
            for (int r = 0; r < 16; ++r) s += win[(size_t)k * 3088 + 3072 + r] * wgu[r * 512 + j];
            WT[(size_t)(3072 + j) * 1024 + k] = f2bf16(s); } }
    {   const float* win = A.in[15]; bf16* WT = (bf16*)(ws + W_FOX_IN);
        for (int i = gt; i < 16 * 1024; i += NGT) { const int j = i >> 10, k = i & 1023; WT[(size_t)(3072 + j) * 1024 + k] = f2bf16(win[(size_t)k * 3088 + 3072 + j]); } }
    {   float* rc = (float*)(ws + WS_ROPC); float* rs = (float*)(ws + WS_ROPS);
        for (int i = gt; i < 8192 * 32; i += NGT) { const int pos = i >> 5, d = i & 31; const double inv = exp(-(double)d * (11.918390573078392 / 32.0));
            const double rev = (double)pos * inv * 0.15915494309189535; const float f = (float)(rev - floor(rev));
            rc[i] = __builtin_amdgcn_cosf(f); rs[i] = __builtin_amdgcn_sinf(f); } }
    {   float* mod = (float*)(ws + WS_MOD); const float* c = A.in[1]; const float* aw = A.in[2]; const float* ab = A.in[3];
        for (int task = gw; task < 4 * 24 * 16; task += NGW) {
            const int kc = task & 15, jb = (task >> 4) % 24, l = task / (16 * 24);
            const int j = jb * 256 + F.lane * 4; const float* wp = aw + ((size_t)l * 1024 + kc * 64) * 6144 + j;
            f32x4 a0 = {0.f, 0.f, 0.f, 0.f}, a1 = {0.f, 0.f, 0.f, 0.f};
#pragma unroll 8
            for (int k = 0; k < 64; ++k) { const f32x4 w = *(const f32x4*)(wp + (size_t)k * 6144); const float c0 = silu_d(c[kc * 64 + k]), c1 = silu_d(c[1024 + kc * 64 + k]); a0 += w * c0; a1 += w * c1; }
            if (kc == 0) { const f32x4 bb = *(const f32x4*)(ab + (size_t)l * 6144 + j); a0 += bb; a1 += bb; }
            float* m0 = mod + ((size_t)l * 2 + 0) * 6144 + j; float* m1 = mod + ((size_t)l * 2 + 1) * 6144 + j;
#pragma unroll
            for (int q = 0; q < 4; ++q) { atomicAdd(m0 + q, a0[q]); atomicAdd(m1 + q, a1[q]); }
        } }
}

__device__ __forceinline__ void p1_prologue(Frame& F, const Args& A) {
    unsigned char* ws = A.ws; const float* mod = (const float*)(ws + WS_MOD); float* shw = (float*)(ws + WS_SHW);
    const int gw = F.vcu * NWAVES + F.wave, NGW = F.G * NWAVES, lane = F.lane;
    for (int sub = 0; sub < 8; ++sub) {
        const int l = sub >> 1; const bf16* WT; int nrows;
        if (sub & 1) { WT = (const bf16*)(ws + W_GU0 + l * W_GU_STRIDE); nrows = 5632; }
        else if (l == 0) { WT = (const bf16*)(ws + W_SWA_IN0); nrows = 1536; }
        else if (l == 1) { WT = (const bf16*)(ws + W_GLA_IN); nrows = 3584; }
        else if (l == 2) { WT = (const bf16*)(ws + W_FOX_IN); nrows = 3088; }
        else { WT = (const bf16*)(ws + W_SWA_IN1); nrows = 1536; }
        const float* sh0 = mod + ((size_t)l * 2 + 0) * 6144 + ((sub & 1) ? 3072 : 0); const float* sh1 = sh0 + 6144;
        float s0[16], s1[16];
#pragma unroll
        for (int q = 0; q < 2; ++q)
#pragma unroll
            for (int e = 0; e < 8; ++e) { s0[q * 8 + e] = sh0[q * 512 + lane * 8 + e]; s1[q * 8 + e] = sh1[q * 512 + lane * 8 + e]; }
        for (int n0 = gw * 4; n0 < nrows; n0 += NGW * 4) {
            v4u w[4][2]; float a0[4], a1[4];
#pragma unroll
            for (int r = 0; r < 4; ++r) { const int n = (n0 + r < nrows) ? n0 + r : nrows - 1;
#pragma unroll
                for (int q = 0; q < 2; ++q) w[r][q] = *(const GAS v4u*)(WT + (size_t)n * 1024 + q * 512 + lane * 8); }
#pragma unroll
            for (int r = 0; r < 4; ++r) { a0[r] = 0.f; a1[r] = 0.f;
#pragma unroll
                for (int q = 0; q < 2; ++q) { const unsigned ww[4] = {w[r][q].x, w[r][q].y, w[r][q].z, w[r][q].w};
#pragma unroll
                    for (int e = 0; e < 4; ++e) { const float lo = __uint_as_float(ww[e] << 16), hi = __uint_as_float(ww[e] & 0xffff0000u);
                        a0[r] += lo * s0[q * 8 + 2 * e] + hi * s0[q * 8 + 2 * e + 1]; a1[r] += lo * s1[q * 8 + 2 * e] + hi * s1[q * 8 + 2 * e + 1]; } } }
#pragma unroll
            for (int o = 1; o < 64; o <<= 1) {
#pragma unroll
                for (int r = 0; r < 4; ++r) { a0[r] += __shfl_xor(a0[r], o); a1[r] += __shfl_xor(a1[r], o); } }
            if (lane == 0) {
#pragma unroll
                for (int r = 0; r < 4; ++r) if (n0 + r < nrows) { shw[((size_t)sub * 2 + 0) * 5632 + n0 + r] = a0[r]; shw[((size_t)sub * 2 + 1) * 5632 + n0 + r] = a1[r]; } }
        }
    }
    const float* x = A.in[0]; const float* ng = A.in[4]; bf16* XA = (bf16*)(ws + WS_XA); float* SS = (float*)(ws + WS_SS);
    for (int row = gw; row < M; row += NGW) {
        const int b = row >> 13; const GAS f32x4* xr = (const GAS f32x4*)(x + (size_t)row * D) + lane; const float* sc = mod + (size_t)b * 6144 + 1024;
        float s = 0.f; GAS unsigned long long* o8 = (GAS unsigned long long*)(XA + (size_t)row * D) + lane;
#pragma unroll
        for (int j = 0; j < 4; ++j) { const f32x4 v = xr[64 * j]; s += (v.x * v.x + v.y * v.y) + (v.z * v.z + v.w * v.w);
            const int k = 256 * j + 4 * lane; const f32x4 g = *(const f32x4*)(ng + k), c = *(const f32x4*)(sc + k); const f32x4 y = v * (g * (c + 1.0f));
            o8[64 * j] = (unsigned long long)pk2(y.x, y.y) | ((unsigned long long)pk2(y.z, y.w) << 32); }
        s = wave_sum(s);
        if (lane < 16) SS[(size_t)row * 16 + lane] = lane == 0 ? s : 0.f;
    }
}

__device__ __forceinline__ void final_norm_phase(Frame& F, const Args& A) {
    const int gw = F.vcu * NWAVES + F.wave, NGW = F.G * NWAVES, lane = F.lane; const float* SS = (const float*)(A.ws + WS_SS); const float* fg = A.in[18];
    for (int row = gw; row < M; row += NGW) {
        const float rs = pg8::row_rstd(SS, row); GAS f32x4* xr = (GAS f32x4*)(A.out + (size_t)row * D) + lane;
#pragma unroll
        for (int j = 0; j < 4; ++j) { const f32x4 v = xr[64 * j]; const f32x4 g = *(const f32x4*)(fg + 256 * j + 4 * lane); xr[64 * j] = v * rs * g; }
    }
}

__device__ __forceinline__ void load_row64(const bf16* p, float (&q)[64]) {
#pragma unroll
    for (int i = 0; i < 8; ++i) { const v4u w = *(const GAS v4u*)(p + 8 * i); const unsigned ww[4] = {w.x, w.y, w.z, w.w};
#pragma unroll
        for (int e = 0; e < 4; ++e) { q[8 * i + 2 * e] = __uint_as_float(ww[e] << 16); q[8 * i + 2 * e + 1] = __uint_as_float(ww[e] & 0xffff0000u); } }
}
__device__ __forceinline__ float dot_row64(const bf16* p, const float (&q)[64]) {
    float s = 0.f;
#pragma unroll
    for (int i = 0; i < 8; ++i) { const v4u w = *(const GAS v4u*)(p + 8 * i); const unsigned ww[4] = {w.x, w.y, w.z, w.w};
#pragma unroll
        for (int e = 0; e < 4; ++e) { s += __uint_as_float(ww[e] << 16) * q[8 * i + 2 * e]; s += __uint_as_float(ww[e] & 0xffff0000u) * q[8 * i + 2 * e + 1]; } }
    return s;
}
__device__ __forceinline__ void swa_simple(Frame& F, const bf16* Q, const bf16* Kb, const bf16* Vb, bf16* O, const float* sinks) {
    const int gw = blockIdx.x * NWAVES + F.wave, NGW = F.G * NWAVES, lane = F.lane;
    for (int task = gw; task < M * 16; task += NGW) {
        const int row = task >> 4, h = task & 15, t = row & 8191, rowb = row - t, kvh = h >> 2;
        float q[64]; load_row64(Q + (size_t)row * 1024 + h * 64, q);
        const int s0 = t - lane, s1 = t - 64 - lane;
        const float sc0 = s0 >= 0 ? dot_row64(Kb + (size_t)(rowb + s0) * 256 + kvh * 64, q) : -INFINITY;
        const float sc1 = s1 >= 0 ? dot_row64(Kb + (size_t)(rowb + s1) * 256 + kvh * 64, q) : -INFINITY;
        const float sk = sinks[h] * LOG2E;
        const float m = fmaxf(wave_max(fmaxf(sc0, sc1)), sk);
        const float p0 = exp2f(sc0 - m), p1 = exp2f(sc1 - m);
        const float l = wave_sum(p0 + p1) + exp2f(sk - m);
        float acc = 0.f;
        for (int j = 0; j < 64; ++j) { const int s = t - j; if (s < 0) break; acc += __shfl(p0, j) * bf2f(Vb[(size_t)(rowb + s) * 256 + kvh * 64 + lane]); }
        for (int j = 0; j < 64; ++j) { const int s = t - 64 - j; if (s < 0) break; acc += __shfl(p1, j) * bf2f(Vb[(size_t)(rowb + s) * 256 + kvh * 64 + lane]); }
        O[(size_t)row * 1024 + h * 64 + lane] = f2bf16(acc / l);
    }
}
__device__ __forceinline__ void fox_simple(Frame& F, const bf16* Q, const bf16* Kb, const bf16* Vb, bf16* O, const float* LCL, const float* BTOT) {
    const int gw = blockIdx.x * NWAVES + F.wave, NGW = F.G * NWAVES, lane = F.lane;
    for (int task = gw; task < M * 16; task += NGW) {
        const int row = task >> 4, h = task & 15, t = row & 8191, rowb = row - t, b = row >> 13;
        float q[64]; load_row64(Q + (size_t)row * 1024 + h * 64, q);
        const float bt = lane < 32 ? BTOT[(b * 16 + h) * 32 + lane] : 0.f; float inc = bt;
#pragma unroll
        for (int o = 1; o < 32; o <<= 1) { const float v = __shfl_up(inc, o); if (lane >= o) inc += v; }
        const float excl = inc - bt;
        const float lct = LCL[(size_t)row * 16 + h] + __shfl(excl, t >> 8);
        float m = -1e30f, l = 0.f, o = 0.f;
        for (int c = 0; c <= (t >> 6); ++c) {
            const int s = 64 * c + lane; const bool valid = s <= t; const float base = __shfl(excl, c >> 2);
            float sc = -INFINITY;
            if (valid) sc = dot_row64(Kb + (size_t)(rowb + s) * 1024 + h * 64, q) + LOG2E * (lct - (LCL[(size_t)(rowb + s) * 16 + h] + base));
            const float mn = fmaxf(m, wave_max(sc)); const float alpha = exp2f(m - mn); const float p = exp2f(sc - mn);
            l = l * alpha + wave_sum(p); o *= alpha;
            const int nj = min(64, t - 64 * c + 1);
            for (int j = 0; j < nj; ++j) o += __shfl(p, j) * bf2f(Vb[(size_t)(rowb + 64 * c + j) * 1024 + h * 64 + lane]);
            m = mn;
        }
        O[(size_t)row * 1024 + h * 64 + lane] = f2bf16(o / l);
    }
}
__device__ __forceinline__ void fox_gate_unit(Frame& F, int blk, const bf16* XA, const bf16* Wf  , const float* SS, const float* shWf  , const float* b_f, float* LCL, float* BTOT) {
    LAS bf16* wl = (LAS bf16*)F.lds; LAS float* lf = (LAS float*)(F.lds + 32768); LAS float* seg = (LAS float*)(F.lds + 32768 + 16384);
    const int tid = F.tid, lane = F.lane, wave = F.wave;
    for (int i = tid; i < 16 * 1024 / 8; i += 512) ((LAS v4u*)wl)[i] = ((const GAS v4u*)Wf)[i];
    LDS_WAIT(); __syncthreads();
    const int b = (blk * 256) >> 13;
    for (int r = 0; r < 32; ++r) {
        const int tl = wave * 32 + r, row = blk * 256 + tl;
        float xa[16];
#pragma unroll
        for (int q = 0; q < 2; ++q) { const v4u w = *(const GAS v4u*)(XA + (size_t)row * 1024 + q * 512 + lane * 8); const unsigned ww[4] = {w.x, w.y, w.z, w.w};
#pragma unroll
            for (int e = 0; e < 4; ++e) { xa[q * 8 + 2 * e] = __uint_as_float(ww[e] << 16); xa[q * 8 + 2 * e + 1] = __uint_as_float(ww[e] & 0xffff0000u); } }
        const float rs = pg8::row_rstd(SS, row);
        float mine = 0.f;
#pragma unroll
        for (int h = 0; h < 16; ++h) { float a = 0.f;
#pragma unroll
            for (int q = 0; q < 2; ++q) { const v4u w = *(const LAS v4u*)(wl + h * 1024 + q * 512 + lane * 8); const unsigned ww[4] = {w.x, w.y, w.z, w.w};
#pragma unroll
                for (int e = 0; e < 4; ++e) { a += __uint_as_float(ww[e] << 16) * xa[q * 8 + 2 * e]; a += __uint_as_float(ww[e] & 0xffff0000u) * xa[q * 8 + 2 * e + 1]; } }
            a = wave_sum(a); if (lane == h) mine = a; }
        if (lane < 16) lf[tl * 16 + lane] = logsig_d(mine * rs + shWf[(size_t)b * 5632 + 3072 + lane] + b_f[lane]);
    }
    LDS_WAIT(); __syncthreads();
    const int h = tid & 15, sg = tid >> 4;
    float loc[8]; float run = 0.f;
#pragma unroll
    for (int i = 0; i < 8; ++i) { run += lf[(sg * 8 + i) * 16 + h]; loc[i] = run; }
    seg[sg * 16 + h] = run;
    LDS_WAIT(); __syncthreads();
    float pre = 0.f;
    for (int s2 = 0; s2 < sg; ++s2) pre += seg[s2 * 16 + h];
#pragma unroll
    for (int i = 0; i < 8; ++i) LCL[(size_t)(blk * 256 + sg * 8 + i) * 16 + h] = pre + loc[i];
    if (sg == 31) BTOT[(b * 16 + h) * 32 + (blk & 31)] = pre + run;
    LDS_WAIT(); __syncthreads();
}

__device__ __forceinline__ void gla_A_simple(Frame& F, bf16* Qg, bf16* Kg, const bf16* Vg, const float* LA, float* EB, bf16* Ag, bf16* KV) {
    LAS float* Bc = (LAS float*)F.lds;
    LAS float* Qp = (LAS float*)(F.lds + 32768);
    LAS float* Kp = (LAS float*)(F.lds + 32768 + 33024);
    LAS bf16* Vl = (LAS bf16*)(F.lds + 32768 + 2 * 33024);
    const int tid = F.tid;
    for (int unit = blockIdx.x; unit < 1024; unit += F.G) {
        const int b = unit >> 9, n = (unit >> 2) & 127, h = unit & 3, row0 = b * 8192 + n * 64;
        for (int i = tid; i < 64 * 128; i += 512) { const int t = i >> 7, d = i & 127; Bc[i] = LA[(size_t)(row0 + t) * 512 + h * 128 + d]; }
        for (int i = tid; i < 64 * 256 / 8; i += 512) { const int t = i >> 5, c = i & 31; ((LAS v4u*)Vl)[i] = *(const GAS v4u*)(Vg + (size_t)(row0 + t) * 1024 + h * 256 + c * 8); }
        LDS_WAIT(); __syncthreads();
        if (tid < 128) { float a = 0.f; for (int t = 0; t < 64; ++t) { a += Bc[t * 128 + tid]; Bc[t * 128 + tid] = a; } EB[(size_t)unit * 128 + tid] = __expf(a); }
        LDS_WAIT(); __syncthreads();
        for (int i = tid; i < 64 * 128; i += 512) { const int t = i >> 7, d = i & 127; const float bb = Bc[i]; const size_t g = (size_t)(row0 + t) * 512 + h * 128 + d;
            const bf16 qp = f2bf16(bf2f(Qg[g]) * __expf(bb)), kp = f2bf16(bf2f(Kg[g]) * __expf(-bb));
            Qg[g] = qp; Kg[g] = kp; Qp[t * 129 + d] = bf2f(qp); Kp[t * 129 + d] = bf2f(kp); }
        LDS_WAIT(); __syncthreads();
        {   const int t = tid >> 3, sg = tid & 7;
#pragma unroll
            for (int i = 0; i < 8; ++i) { const int s = sg + 8 * i; float a = 0.f;
                if (s <= t) { for (int d = 0; d < 128; ++d) a += Qp[t * 129 + d] * Kp[s * 129 + d]; }
                Ag[(size_t)unit * 4096 + t * 64 + s] = f2bf16(a); } }
        {   const int d = tid >> 2, eg = tid & 3;
            float acc[64];
#pragma unroll
            for (int i = 0; i < 64; ++i) acc[i] = 0.f;
            for (int s = 0; s < 64; ++s) { const float kp = Kp[s * 129 + d];
#pragma unroll
                for (int i = 0; i < 32; ++i) { const unsigned w = *(const LAS unsigned*)(Vl + s * 256 + eg * 64 + 2 * i); acc[2 * i] += kp * __uint_as_float(w << 16); acc[2 * i + 1] += kp * __uint_as_float(w & 0xffff0000u); } }
            bf16* dst = KV + ((size_t)unit * 128 + d) * 256 + eg * 64;
#pragma unroll
            for (int i = 0; i < 8; ++i) { v4u o; o.x = pk2(acc[8 * i], acc[8 * i + 1]); o.y = pk2(acc[8 * i + 2], acc[8 * i + 3]); o.z = pk2(acc[8 * i + 4], acc[8 * i + 5]); o.w = pk2(acc[8 * i + 6], acc[8 * i + 7]); *(GAS v4u*)(dst + 8 * i) = o; } }
        LDS_WAIT(); __syncthreads();
    }
}
__device__ __forceinline__ void gla_B_scan(Frame& F, bf16* KV, const float* EB) {
    const int idx = blockIdx.x * 512 + F.tid;
    for (int p = idx; p < 131072; p += F.G * 512) {
        const int e2 = p & 127, d = (p >> 7) & 127, h = (p >> 14) & 3, b = p >> 16;
        float s0 = 0.f, s1 = 0.f;
        for (int n0 = 0; n0 < 128; n0 += 16) {
            unsigned kv[16]; float eb[16];
#pragma unroll
            for (int i = 0; i < 16; ++i) { const size_t unit = (size_t)(b * 128 + n0 + i) * 4 + h; kv[i] = *(const GAS unsigned*)(KV + (unit * 128 + d) * 256 + 2 * e2); eb[i] = EB[unit * 128 + d]; }
#pragma unroll
            for (int i = 0; i < 16; ++i) { const size_t unit = (size_t)(b * 128 + n0 + i) * 4 + h;
                *(GAS unsigned*)(KV + (unit * 128 + d) * 256 + 2 * e2) = pk2(s0, s1);
                s0 = eb[i] * (s0 + __uint_as_float(kv[i] << 16)); s1 = eb[i] * (s1 + __uint_as_float(kv[i] & 0xffff0000u)); }
        }
    }
}
__device__ __forceinline__ void gla_C_simple(Frame& F, const bf16* Qg, const bf16* Vg, const bf16* SR, const bf16* Ag, const bf16* Sg, const float* hn, bf16* O) {
    LAS bf16* Sl = (LAS bf16*)F.lds;
    LAS bf16* Vl = (LAS bf16*)(F.lds + 65536);
    LAS float* Al = (LAS float*)(F.lds + 98304);
    LAS float* Ql = (LAS float*)(F.lds + 98304 + 16640);
    LAS bf16* Qb = (LAS bf16*)Ql;
    const int tid = F.tid;
    for (int unit = blockIdx.x; unit < 1024; unit += F.G) {
        const int b = unit >> 9, n = (unit >> 2) & 127, h = unit & 3, row0 = b * 8192 + n * 64;
        for (int i = tid; i < 128 * 256 / 8; i += 512) ((LAS v4u*)Sl)[i] = *(const GAS v4u*)(Sg + (size_t)unit * 32768 + (size_t)i * 8);
        for (int i = tid; i < 64 * 256 / 8; i += 512) { const int t = i >> 5, c = i & 31; ((LAS v4u*)Vl)[i] = *(const GAS v4u*)(Vg + (size_t)(row0 + t) * 1024 + h * 256 + c * 8); }
        for (int i = tid; i < 4096; i += 512) Al[(i >> 6) * 65 + (i & 63)] = bf2f(Ag[(size_t)unit * 4096 + i]);
        for (int i = tid; i < 64 * 128; i += 512) { const int t = i >> 7, d = i & 127; Qb[t * 136 + d] = Qg[(size_t)(row0 + t) * 512 + h * 128 + d]; }
        LDS_WAIT(); __syncthreads();
        const int t = tid >> 3, eg = tid & 7;
        float acc[32];
#pragma unroll
        for (int i = 0; i < 32; ++i) acc[i] = 0.f;
        for (int s = 0; s < 64; ++s) { const float a = Al[t * 65 + s];
#pragma unroll
            for (int i = 0; i < 16; ++i) { const unsigned w = *(const LAS unsigned*)(Vl + s * 256 + eg * 32 + 2 * i); acc[2 * i] += a * __uint_as_float(w << 16); acc[2 * i + 1] += a * __uint_as_float(w & 0xffff0000u); } }
        for (int d = 0; d < 128; ++d) { const float qv = bf2f(Qb[t * 136 + d]);
#pragma unroll
            for (int i = 0; i < 16; ++i) { const unsigned w = *(const LAS unsigned*)(Sl + d * 256 + eg * 32 + 2 * i); acc[2 * i] += qv * __uint_as_float(w << 16); acc[2 * i + 1] += qv * __uint_as_float(w & 0xffff0000u); } }
        float ss = 0.f;
#pragma unroll
        for (int i = 0; i < 32; ++i) ss += acc[i] * acc[i];
        ss += __shfl_xor(ss, 1); ss += __shfl_xor(ss, 2); ss += __shfl_xor(ss, 4);
        const float rs = 1.0f / sqrtf(ss * (1.0f / 256.0f) + EPS);
        const bf16* srp = SR + (size_t)(row0 + t) * 1024 + h * 256 + eg * 32; bf16* op = O + (size_t)(row0 + t) * 1024 + h * 256 + eg * 32;
#pragma unroll
        for (int i = 0; i < 4; ++i) { const v4u w = *(const GAS v4u*)(srp + 8 * i); const unsigned ww[4] = {w.x, w.y, w.z, w.w}; unsigned oo[4];
#pragma unroll
            for (int e = 0; e < 4; ++e) { const int c = 8 * i + 2 * e; const float v0 = acc[c] * rs * hn[eg * 32 + c] * __uint_as_float(ww[e] << 16), v1 = acc[c + 1] * rs * hn[eg * 32 + c + 1] * __uint_as_float(ww[e] & 0xffff0000u); oo[e] = pk2(v0, v1); }
            v4u o; o.x = oo[0]; o.y = oo[1]; o.z = oo[2]; o.w = oo[3]; *(GAS v4u*)(op + 8 * i) = o; }
        LDS_WAIT(); __syncthreads();
    }
}


typedef short s16x4_t __attribute__((ext_vector_type(4)));
typedef float f32x16 __attribute__((ext_vector_type(16)));
__device__ __forceinline__ bf16x8 frag_row(const LAS unsigned char* img, int pitch, int row0, int k0, int lane) {
    return *(const LAS bf16x8*)(img + (row0 + (lane & 31)) * pitch + (k0 + 8 * (lane >> 5)) * 2);
}
__device__ __forceinline__ bf16x8 frag_tr(const LAS unsigned char* img, int pitch, int k0, int col0, int lane) {
    const int g = lane >> 4, i = lane & 15, q = i >> 2, pp = i & 3;
    const LAS unsigned char* a = img + (k0 + 8 * (g >> 1) + q) * pitch + (col0 + 16 * (g & 1) + 4 * pp) * 2;
    const s16x4_t lo = __builtin_bit_cast(s16x4_t, __builtin_amdgcn_ds_read_tr16_b64_v4i16((LAS s16x4_t*)a));
    const s16x4_t hi = __builtin_bit_cast(s16x4_t, __builtin_amdgcn_ds_read_tr16_b64_v4i16((LAS s16x4_t*)(a + 4 * pitch)));
    return (bf16x8){lo[0], lo[1], lo[2], lo[3], hi[0], hi[1], hi[2], hi[3]};
}
__device__ __forceinline__ int crow32(int r, int hi) { return (r & 3) + 8 * (r >> 2) + 4 * hi; }
__device__ __forceinline__ void fox_lf_block(Frame& F, int blk, const bf16* XA, const bf16* Wf  , const float* SS, const float* shWf, const float* b_f, float* LFT) {
    LAS float* Pl = (LAS float*)F.lds;
    const int tid = F.tid, lane = F.lane, wave = F.wave, r32 = lane & 31, hi = lane >> 5, tt = wave & 1, kq = wave >> 1, row0 = blk * 64;
    const bf16* ap = XA + (size_t)(row0 + 32 * tt + r32) * 1024 + 256 * kq + 8 * hi; const bf16* bp = Wf + (size_t)r32 * 1024 + 256 * kq + 8 * hi;
    f32x16 acc = {};
#pragma unroll 4
    for (int ks = 0; ks < 16; ++ks) { const bf16x8 a = *(const GAS bf16x8*)(ap + 16 * ks), bfr = *(const GAS bf16x8*)(bp + 16 * ks); acc = __builtin_amdgcn_mfma_f32_32x32x16_bf16(a, bfr, acc, 0, 0, 0); }
    if (r32 < 16) {
#pragma unroll
        for (int r = 0; r < 16; ++r) Pl[(kq * 64 + 32 * tt + crow32(r, hi)) * 16 + r32] = acc[r];
    }
    LDS_WAIT(); __syncthreads();
    {   const int t = tid >> 3, h0 = 2 * (tid & 7), row = row0 + t, b = row >> 13; const float rs = pg8::row_rstd(SS, row);
#pragma unroll
        for (int z = 0; z < 2; ++z) { const int h = h0 + z; const float s = (Pl[(0 * 64 + t) * 16 + h] + Pl[(1 * 64 + t) * 16 + h]) + (Pl[(2 * 64 + t) * 16 + h] + Pl[(3 * 64 + t) * 16 + h]);
            LFT[((size_t)(b * 16 + h)) * 8192 + (row & 8191)] = logsig_d(s * rs + shWf[(size_t)b * 5632 + 3072 + h] + b_f[h]); } }
    LDS_WAIT(); __syncthreads();
}
constexpr int GP_Q = 272, GP_V = 576, GP_A = 144, GP_ST = 1040;

__device__ __forceinline__ void gla_A_mfma(Frame& F, bf16* Qg, const bf16* Kg, const bf16* Vg, const float* LA, float* EB, bf16* Ag, bf16* KV) {
    LAS float* Bc = (LAS float*)F.lds;
    LAS float* Tot = (LAS float*)(F.lds + 32768);
    LAS unsigned char* Qi = F.lds + 34816;
    LAS unsigned char* Ki = F.lds + 34816 + 17408;
    LAS unsigned char* Vi = F.lds + 34816 + 2 * 17408;
    const int tid = F.tid, lane = F.lane, wave = F.wave;
    for (int unit = blockIdx.x; unit < 1024; unit += F.G) {
        const int b = unit >> 9, n = (unit >> 2) & 127, h = unit & 3, row0 = b * 8192 + n * 64;
        for (int i = tid; i < 64 * 32; i += 512) { const int t = i >> 5, c = i & 31; *(LAS f32x4*)(Bc + t * 128 + c * 4) = *(const GAS f32x4*)(LA + (size_t)(row0 + t) * 512 + h * 128 + c * 4); }
        for (int i = tid; i < 64 * 32; i += 512) { const int t = i >> 5, c = i & 31; *(LAS v4u*)(Vi + t * GP_V + c * 16) = *(const GAS v4u*)(Vg + (size_t)(row0 + t) * 1024 + h * 256 + c * 8); }
        LDS_WAIT(); __syncthreads();
        {   const int d = tid & 127, sg = tid >> 7; float a = 0.f;
#pragma unroll
            for (int t = 0; t < 16; ++t) { a += Bc[(sg * 16 + t) * 128 + d]; Bc[(sg * 16 + t) * 128 + d] = a; }
            Tot[sg * 128 + d] = a; }
        LDS_WAIT(); __syncthreads();
        if (tid < 128) EB[(size_t)unit * 128 + tid] = __expf(Tot[tid] + Tot[128 + tid] + Tot[256 + tid] + Tot[384 + tid]);
        for (int i = tid; i < 64 * 16; i += 512) { const int t = i >> 4, c = i & 15, sg = t >> 4; const size_t g = (size_t)(row0 + t) * 512 + h * 128 + c * 8;
            const v4u qv = *(const GAS v4u*)(Qg + g), kv = *(const GAS v4u*)(Kg + g); const unsigned qq[4] = {qv.x, qv.y, qv.z, qv.w}, kk[4] = {kv.x, kv.y, kv.z, kv.w}; unsigned qo[4], ko[4];
#pragma unroll
            for (int e = 0; e < 4; ++e) { float bb[2];
#pragma unroll
                for (int z = 0; z < 2; ++z) { const int d = c * 8 + 2 * e + z; float v = Bc[t * 128 + d]; if (sg > 0) v += Tot[d]; if (sg > 1) v += Tot[128 + d]; if (sg > 2) v += Tot[256 + d]; bb[z] = v; }
                const float e0 = __expf(bb[0]), e1 = __expf(bb[1]);
                qo[e] = pk2(__uint_as_float(qq[e] << 16) * e0, __uint_as_float(qq[e] & 0xffff0000u) * e1);
                ko[e] = pk2(__uint_as_float(kk[e] << 16) / e0, __uint_as_float(kk[e] & 0xffff0000u) / e1); }
            v4u qw; qw.x = qo[0]; qw.y = qo[1]; qw.z = qo[2]; qw.w = qo[3]; v4u kw; kw.x = ko[0]; kw.y = ko[1]; kw.z = ko[2]; kw.w = ko[3];
            *(GAS v4u*)(Qg + g) = qw; *(LAS v4u*)(Qi + t * GP_Q + c * 16) = qw; *(LAS v4u*)(Ki + t * GP_Q + c * 16) = kw; }
        LDS_WAIT(); __syncthreads();
        const int r32 = lane & 31, hi = lane >> 5;
        if (wave < 4) {
            const int tt = wave & 1, st = wave >> 1; f32x16 acc = {};
            if (st <= tt) {
#pragma unroll
                for (int ks = 0; ks < 8; ++ks) acc = __builtin_amdgcn_mfma_f32_32x32x16_bf16(frag_row(Qi, GP_Q, 32 * tt, 16 * ks, lane), frag_row(Ki, GP_Q, 32 * st, 16 * ks, lane), acc, 0, 0, 0);
            }
            bf16* dst = Ag + (size_t)unit * 4096 + 32 * st + r32;
#pragma unroll
            for (int r = 0; r < 16; ++r) { const int t = 32 * tt + crow32(r, hi), s = 32 * st + r32; dst[t * 64] = f2bf16(s <= t ? acc[r] : 0.f); }
        }
        {   const int dt = wave & 3, eb0 = (wave >> 2) * 4;
            f32x16 acc[4] = {};
#pragma unroll
            for (int ks = 0; ks < 4; ++ks) { const bf16x8 a = frag_tr(Ki, GP_Q, 16 * ks, 32 * dt, lane);
#pragma unroll
                for (int j = 0; j < 4; ++j) acc[j] = __builtin_amdgcn_mfma_f32_32x32x16_bf16(a, frag_tr(Vi, GP_V, 16 * ks, 32 * (eb0 + j), lane), acc[j], 0, 0, 0); }
            bf16* dst = KV + ((size_t)unit * 128 + 32 * dt) * 256 + r32;
#pragma unroll
            for (int j = 0; j < 4; ++j)
#pragma unroll
                for (int r = 0; r < 16; ++r) dst[(size_t)crow32(r, hi) * 256 + 32 * (eb0 + j)] = f2bf16(acc[j][r]);
        }
        LDS_WAIT(); __syncthreads();
    }
}
__device__ __forceinline__ void gla_C_mfma(Frame& F, const bf16* Qg, const bf16* Vg, const bf16* SR, const bf16* Ag, const bf16* Sg, const float* hn, bf16* O) {
    LAS unsigned char* Si = F.lds;
    LAS unsigned char* Vi = F.lds + 73728;
    LAS unsigned char* Ai = F.lds + 73728 + 36864;
    LAS unsigned char* Qi = F.lds + 73728 + 36864 + 9216;
    const int tid = F.tid, lane = F.lane, wave = F.wave;
    for (int unit = blockIdx.x; unit < 1024; unit += F.G) {
        const int b = unit >> 9, n = (unit >> 2) & 127, h = unit & 3, row0 = b * 8192 + n * 64;
        for (int i = tid; i < 128 * 32; i += 512) { const int d = i >> 5, c = i & 31; *(LAS v4u*)(Si + d * GP_V + c * 16) = *(const GAS v4u*)(Sg + (size_t)unit * 32768 + d * 256 + c * 8); }
        for (int i = tid; i < 64 * 32; i += 512) { const int t = i >> 5, c = i & 31; *(LAS v4u*)(Vi + t * GP_V + c * 16) = *(const GAS v4u*)(Vg + (size_t)(row0 + t) * 1024 + h * 256 + c * 8); }
        { const int t = tid >> 3, c = tid & 7; *(LAS v4u*)(Ai + t * GP_A + c * 16) = *(const GAS v4u*)(Ag + (size_t)unit * 4096 + t * 64 + c * 8); }
        for (int i = tid; i < 64 * 16; i += 512) { const int t = i >> 4, c = i & 15; *(LAS v4u*)(Qi + t * GP_Q + c * 16) = *(const GAS v4u*)(Qg + (size_t)(row0 + t) * 512 + h * 128 + c * 8); }
        LDS_WAIT(); __syncthreads();
        const int tt = wave & 1, et0 = (wave >> 1) * 2, r32 = lane & 31, hi = lane >> 5;
        f32x16 acc[2] = {};
#pragma unroll
        for (int ks = 0; ks < 4; ++ks) { const bf16x8 a = frag_row(Ai, GP_A, 32 * tt, 16 * ks, lane);
#pragma unroll
            for (int j = 0; j < 2; ++j) acc[j] = __builtin_amdgcn_mfma_f32_32x32x16_bf16(a, frag_tr(Vi, GP_V, 16 * ks, 32 * (et0 + j), lane), acc[j], 0, 0, 0); }
#pragma unroll
        for (int ks = 0; ks < 8; ++ks) { const bf16x8 a = frag_row(Qi, GP_Q, 32 * tt, 16 * ks, lane);
#pragma unroll
            for (int j = 0; j < 2; ++j) acc[j] = __builtin_amdgcn_mfma_f32_32x32x16_bf16(a, frag_tr(Si, GP_V, 16 * ks, 32 * (et0 + j), lane), acc[j], 0, 0, 0); }
        LDS_WAIT(); __syncthreads();
        LAS float* St = (LAS float*)Si;
#pragma unroll
        for (int j = 0; j < 2; ++j)
#pragma unroll
            for (int r = 0; r < 16; ++r) St[(32 * tt + crow32(r, hi)) * (GP_ST / 4) + 32 * (et0 + j) + r32] = acc[j][r];
        LDS_WAIT(); __syncthreads();
        {   const int t = tid >> 3, eg = tid & 7; float a[32];
#pragma unroll
            for (int i = 0; i < 8; ++i) { const f32x4 v = *(const LAS f32x4*)(St + t * (GP_ST / 4) + eg * 32 + 4 * i); a[4 * i] = v.x; a[4 * i + 1] = v.y; a[4 * i + 2] = v.z; a[4 * i + 3] = v.w; }
            float ss = 0.f;
#pragma unroll
            for (int i = 0; i < 32; ++i) ss += a[i] * a[i];
            ss += __shfl_xor(ss, 1); ss += __shfl_xor(ss, 2); ss += __shfl_xor(ss, 4);
            const float rs = 1.0f / sqrtf(ss * (1.0f / 256.0f) + EPS);
            const bf16* srp = SR + (size_t)(row0 + t) * 1024 + h * 256 + eg * 32; bf16* op = O + (size_t)(row0 + t) * 1024 + h * 256 + eg * 32;
#pragma unroll
            for (int i = 0; i < 4; ++i) { const v4u w = *(const GAS v4u*)(srp + 8 * i); const unsigned ww[4] = {w.x, w.y, w.z, w.w}; unsigned oo[4];
#pragma unroll
                for (int e = 0; e < 4; ++e) { const int c = 8 * i + 2 * e; const float v0 = a[c] * rs * hn[eg * 32 + c] * __uint_as_float(ww[e] << 16), v1 = a[c + 1] * rs * hn[eg * 32 + c + 1] * __uint_as_float(ww[e] & 0xffff0000u); oo[e] = pk2(v0, v1); }
                v4u o; o.x = oo[0]; o.y = oo[1]; o.z = oo[2]; o.w = oo[3]; *(GAS v4u*)(op + 8 * i) = o; } }
        LDS_WAIT(); __syncthreads();
    }
}

__device__ __forceinline__ Frame make_frame(unsigned char* lds_generic) {
    Frame F; int t = threadIdx.x; asm volatile("" : "+v"(t));
    F.lds = (LAS unsigned char*)lds_generic; F.MISC = (volatile LAS unsigned*)(F.lds + MISC_OFF);
    F.tid = t; F.lane = t & 63; F.wave = __builtin_amdgcn_readfirstlane(t >> 6);
    F.G = gridDim.x; { const int bx = blockIdx.x; F.vcu = (F.G % 8 == 0) ? (bx % 8) * (F.G / 8) + bx / 8 : bx; }
    F.ctl = nullptr;
    return F;
}
__global__ void __launch_bounds__(NWAVES * 64, 2) skel_fwd(Args args) {
    extern __shared__ __attribute__((aligned(16))) unsigned char lds[];
    {   LAS unsigned char* l3 = (LAS unsigned char*)lds;
        for (int u = threadIdx.x; u < (LDS_BYTES - LDSCTL_OFF) / 4; u += NWAVES * 64) ((LAS unsigned*)(l3 + LDSCTL_OFF))[u] = 0u;
        __syncthreads(); }
#if !MK_MULTI
    XcdBarrier bar = xcd_barrier_post((unsigned*)((gu32*)(args.ws + WS_CTL) + CW_BAR), (volatile LAS unsigned*)((LAS unsigned char*)lds + MISC_OFF) + 8);
#endif
    const int lo = args.ph_lo, hi = args.ph_hi; int ph = 0;
#define PH_ON (ph >= lo && ph < hi)
#if MK_MULTI
#define PH_BEGINC(cls) if (PH_ON) { { Frame F = make_frame(lds); unsigned char* ws = args.ws; asm volatile("" : "+s"(ws)); int l = lraw; asm volatile("" : "+s"(l)); (void)F; (void)l;
#define PH_END } } ++ph;
#else
#define PH_BEGINC(cls) if (PH_ON) { for (int rep_ = 0; rep_ < (((PROBE_MASK) & (cls)) ? 2 : 1); ++rep_) { if (rep_) xcd_barrier(bar); Frame F = make_frame(lds); unsigned char* ws = args.ws; asm volatile("" : "+s"(ws)); int l = lraw; asm volatile("" : "+s"(l)); (void)F; (void)l;
#define PH_END } } if (PH_ON && (ph + 1) < hi) xcd_barrier(bar); ++ph;
#endif
#define PH_BEGIN PH_BEGINC(0)
#define P_MOD ((const float*)(ws + WS_MOD))
#define P_SS ((float*)(ws + WS_SS))
#define P_SHW(sub) ((const float*)(ws + WS_SHW) + (size_t)(sub) * 2 * 5632)
#define P_XA ((bf16*)(ws + WS_XA))
#define P_R (ws + WS_R)
    int lraw = 0;
    PH_BEGIN p0_prologue(F, args); PH_END
    PH_BEGINC(32) p1_prologue(F, args); PH_END

    for (lraw = 0; lraw < DEPTH; ++lraw) {
        const int kind = lraw % 3;
        if (kind == 0) {
            PH_BEGINC(1)
                const int j = l / 3;
                pg8::Gemm g{P_XA, (const bf16*)(ws + (j ? W_SWA_IN1 : W_SWA_IN0)), M, 1536, 1024}; pg8::StaticOrder S; S.init(M, 1536, F.G, (int)blockIdx.x);
                pg8::EpiSwaIn E{P_SS, P_SHW(2 * l), (const float*)(ws + WS_ROPC), (const float*)(ws + WS_ROPS), (bf16*)(P_R + R_SQ), (bf16*)(P_R + R_SK), (bf16*)(P_R + R_SV)};
                pg8::gemm_phase<pg8::EpiSwaIn, pg8::StaticOrder, true, true>(F.lds, g, S, E);
            PH_END
            PH_BEGINC(4)
                attn_body::swa_phase((char*)lds, (const attn_body::bf16*)(P_R + R_SQ), (const attn_body::bf16*)(P_R + R_SK), (const attn_body::bf16*)(P_R + R_SV), (attn_body::bf16*)(P_R + R_SO), args.in[8] + (l / 3) * 16, (int)F.G, (int)blockIdx.x);
            PH_END
        } else if (kind == 1) {
            PH_BEGINC(1)
                pg8::Gemm g{P_XA, (const bf16*)(ws + W_GLA_IN), M, 3584, 1024}; pg8::StaticOrder S; S.init(M, 3584, F.G, (int)blockIdx.x);
                pg8::EpiGlaIn E{P_SS, P_SHW(2 * l), args.in[12], (bf16*)P_R};
                static_assert(R_GQ == 0 && R_GK == 16 * MiB && R_GV == 32 * MiB && R_GSR == 64 * MiB && R_GLA == 96 * MiB, "EpiGlaIn offsets");
                pg8::gemm_phase<pg8::EpiGlaIn, pg8::StaticOrder, true, true>(F.lds, g, S, E);
            PH_END
            PH_BEGIN
                gla_A_mfma(F, (bf16*)(P_R + R_GQ), (const bf16*)(P_R + R_GK), (const bf16*)(P_R + R_GV), (const float*)(P_R + R_GLA), (float*)(ws + WS_EB), (bf16*)(P_R + R_GA), (bf16*)(P_R + R_GKV));
            PH_END
            PH_BEGIN
                gla_B_scan(F, (bf16*)(P_R + R_GKV), (const float*)(ws + WS_EB));
            PH_END
            PH_BEGINC(16)
                gla_C_mfma(F, (const bf16*)(P_R + R_GQ), (const bf16*)(P_R + R_GV), (const bf16*)(P_R + R_GSR), (const bf16*)(P_R + R_GA), (const bf16*)(P_R + R_GKV), args.in[13], (bf16*)(P_R + R_GO));
            PH_END
        } else {
            PH_BEGINC(1)
                pg8::Gemm g{P_XA, (const bf16*)(ws + W_FOX_IN), M, 3072, 1024}; pg8::StaticOrder S; S.init(M, 3072, F.G, (int)blockIdx.x);
                pg8::EpiFoxIn E{P_SS, P_SHW(2 * l), (bf16*)(P_R + R_FQ), (size_t)(R_FK - R_FQ) / 2, (int*)((gu32*)(ws + WS_CTL) + CW_NRM)};
                static_assert(R_FV - R_FK == R_FK - R_FQ, "EpiFoxIn stride");
                pg8::gemm_phase<pg8::EpiFoxIn, pg8::StaticOrder, true, true>(F.lds, g, S, E);
                for (int blk = blockIdx.x; blk < M / 64; blk += F.G)
                    fox_lf_block(F, blk, P_XA, (const bf16*)(ws + W_FOX_IN) + (size_t)3072 * 1024, P_SS, P_SHW(2 * l), args.in[16], (float*)(ws + WS_LCL));
            PH_END
            PH_BEGINC(8)
                static_assert(attn_body::ATTN_LDS_BYTES + 32768 + 128 <= LDSCTL_OFF && attn_body::ATTN_PITCH == D, "attention body geometry vs frame");
                const attn_body::AttnTensors AT{(const attn_body::bf16*)(P_R + R_FQ), (const attn_body::bf16*)(P_R + R_FK), (const attn_body::bf16*)(P_R + R_FV), (attn_body::bf16*)(P_R + R_FO)};
                attn_body::fox_phase<30>((char*)lds, AT, (const float*)(ws + WS_LCL), (const int*)((gu32*)(ws + WS_CTL) + CW_NRM), (unsigned*)((gu32*)(ws + WS_CTL) + CW_QH) + rep_ * 4096, F.vcu);
            PH_END
        }
        PH_BEGIN
            const int kd = l % 3; const float* modl = P_MOD + (size_t)l * 2 * 6144;
            const bf16* Omix = (const bf16*)(P_R + (kd == 0 ? R_SO : (kd == 1 ? R_GO : R_FO)));
            const bf16* Wo = (const bf16*)(ws + (kd == 0 ? (l ? W_SWA_O1 : W_SWA_O0) : (kd == 1 ? W_GLA_O : W_FOX_O)));
            pg8::Gemm g{Omix, Wo, M, 1024, 1024}; pg8::StaticOrder S; S.init(M, 1024, F.G, (int)blockIdx.x);
            pg8::EpiResid E{l == 0 ? args.in[0] : (const float*)args.out, args.out, P_XA, P_SS, modl + 2048, modl + 4096, args.in[4] + (size_t)(2 * l + 1) * 1024};
            pg8::gemm_phase<pg8::EpiResid, pg8::StaticOrder, false, true>(F.lds, g, S, E);
        PH_END
        PH_BEGINC(2)
            pg8::Gemm g{P_XA, (const bf16*)(ws + W_GU0 + l * W_GU_STRIDE), M, NGU, 1024}; pg8::StaticOrder S; S.init(M, NGU, F.G, (int)blockIdx.x);
            pg8::EpiFfnGu E{P_SS, P_SHW(2 * l + 1), (bf16*)(P_R + R_H)};
            pg8::gemm_phase<pg8::EpiFfnGu, pg8::StaticOrder, true, true>(F.lds, g, S, E);
        PH_END
        PH_BEGIN
            const float* modl = P_MOD + (size_t)l * 2 * 6144; const bool last = (l == DEPTH - 1);
            pg8::Gemm g{(const bf16*)(P_R + R_H), (const bf16*)(ws + W_DN0 + l * W_DN_STRIDE), M, 1024, DFF}; pg8::StaticOrder S; S.init(M, 1024, F.G, (int)blockIdx.x);
            pg8::EpiResid E{args.out, args.out, P_XA, P_SS, modl + 5120, last ? nullptr : (modl + 2 * 6144 + 1024), last ? nullptr : (args.in[4] + (size_t)(2 * l + 2) * 1024)};
            pg8::gemm_phase<pg8::EpiResid, pg8::StaticOrder, false, true>(F.lds, g, S, E);
        PH_END
    }
    lraw = 0;
    PH_BEGIN final_norm_phase(F, args); PH_END
#undef PH_ON
#undef PH_BEGIN
#undef PH_END
}

extern "C" void kernel_launch(void* const* d_in, const int* in_sizes, int n_in, void* d_out, int out_size, void* d_ws, size_t ws_size, hipStream_t stream) {
    static int grid = 0;
    if (grid == 0) {
        if (n_in != 19 || in_sizes[0] != M * D || out_size != M * D || ws_size < WS_END) { fprintf(stderr, "kernel_launch: unexpected problem shape (n_in %d, in0 %d, out %d, ws %zu)\n", n_in, n_in > 0 ? in_sizes[0] : -1, out_size, ws_size); grid = -1; return; }
        int dev = 0, cus = 0;
        if (hipGetDevice(&dev) != hipSuccess || hipDeviceGetAttribute(&cus, hipDeviceAttributeMultiprocessorCount, dev) != hipSuccess) { grid = -1; return; }
        if (hipFuncSetAttribute((const void*)skel_fwd, hipFuncAttributeMaxDynamicSharedMemorySize, LDS_BYTES) != hipSuccess) { fprintf(stderr, "kernel_launch: hipFuncSetAttribute failed\n"); grid = -1; return; }
        (void)hipGetLastError();
        grid = cus;
    }
    if (grid < 0) return;
    if (hipMemsetAsync((char*)d_ws + WS_CTL, 0, CTL_ZERO_BYTES, stream) != hipSuccess) return;
    Args a{};
    for (int i = 0; i < 19; ++i) a.in[i] = (const float*)d_in[i];
    a.out = (float*)d_out; a.ws = (unsigned char*)d_ws;
#if MK_MULTI
    for (int p = 0; p < NPHASES; ++p) { a.ph_lo = p; a.ph_hi = p + 1; a.li = 0; hipLaunchKernelGGL(skel_fwd, dim3(grid), dim3(NWAVES * 64), LDS_BYTES, stream, a); }
#else
    a.ph_lo = 0; a.ph_hi = NPHASES; a.li = 0;
    hipLaunchKernelGGL(skel_fwd, dim3(grid), dim3(NWAVES * 64), LDS_BYTES, stream, a);
#endif
}
```
